# Optimizing an MI355X kernel written in HIP

```python
import math
import jax
import jax.numpy as jnp
from jax import lax
import numpy as np

D_MODEL = 1024
BATCH = 16
SEQ = 4096
DEPTH = 2
DEC_BATCH = 8
DEC_SEQ = 64
PAST_LEN = 4096

CHUNK = 64
MIX_WIDTH = D_MODEL
GDN_HEADS = 4
GDN_HEAD_DIM = 128
GDN_WIDTH = GDN_HEADS * GDN_HEAD_DIM
QKV_WIDTH = 3 * GDN_WIDTH
CONV_W = 4
SMLP_GROUPS = 4
SMLP_WIDTH = MIX_WIDTH - GDN_WIDTH
SMLP_GROUP_DIM = SMLP_WIDTH // SMLP_GROUPS
SMLP_CHUNK = 128
D_FF = 4 * D_MODEL
IN_WIDTH = QKV_WIDTH + GDN_WIDTH + 2 * GDN_HEADS + 2 * SMLP_WIDTH
SPLITS = (QKV_WIDTH,
          QKV_WIDTH + GDN_WIDTH,
          QKV_WIDTH + GDN_WIDTH + GDN_HEADS,
          QKV_WIDTH + GDN_WIDTH + 2 * GDN_HEADS,
          QKV_WIDTH + GDN_WIDTH + 2 * GDN_HEADS + SMLP_WIDTH)
DN_ALPHA = (2 * DEPTH) ** 0.25
DN_BETA = (8 * DEPTH) ** -0.25
LN_EPS = 1e-5
NORM_EPS = 1e-6

kernel_name = 'hybrid_gdn_smlp_stream_step'


def layer_norm(x, g, b):
    xf = x.astype(jnp.float32)
    mu = xf.mean(-1, keepdims=True)
    var = jnp.square(xf - mu).mean(-1, keepdims=True)
    y = (xf - mu) * lax.rsqrt(var + LN_EPS) * g.astype(jnp.float32) + b.astype(jnp.float32)
    return y.astype(x.dtype)


def l2norm(x):
    return x * lax.rsqrt(jnp.sum(jnp.square(x), -1, keepdims=True) + NORM_EPS)


def causal_conv_silu(x, tail, w):
    t = x.shape[1]
    xc = jnp.concatenate([tail.astype(x.dtype), x], axis=1)
    y = sum(xc[:, j:j + t] * w[j] for j in range(CONV_W))
    return jax.nn.silu(y), xc[:, -(CONV_W - 1):]


def gated_delta_rule(q, k, v, g, beta, s0):
    bsz, t, h, dk = q.shape
    dv = v.shape[-1]
    n = -(-t // CHUNK)
    pad = n * CHUNK - t

    def to_blocks(a):
        a = jnp.pad(a, [(0, 0), (0, pad)] + [(0, 0)] * (a.ndim - 2))
        a = a.reshape((bsz, n, CHUNK) + a.shape[2:])
        return jnp.moveaxis(a, 3, 1)

    qc, kc, vc, gc, bc = (to_blocks(a) for a in (q, k, v, g, beta))
    gcum = jnp.cumsum(gc, axis=-1)
    causal = jnp.tril(jnp.ones((CHUNK, CHUNK), bool))
    strict = jnp.tril(jnp.ones((CHUNK, CHUNK), bool), -1)
    decay = jnp.exp(jnp.where(causal, gcum[..., :, None] - gcum[..., None, :], -jnp.inf))
    kb = kc * bc[..., None]
    a_mat = jnp.where(strict, jnp.einsum('bhncd,bhnsd->bhncs', kb, kc) * decay, 0.0)
    eye = jnp.eye(CHUNK, dtype=jnp.float32)
    rhs = jnp.concatenate([vc * bc[..., None], kb * jnp.exp(gcum)[..., None]], axis=-1)
    sol = lax.linalg.triangular_solve(a_mat + eye, rhs, left_side=True, lower=True,
                                      unit_diagonal=True)
    u_blk, w_blk = sol[..., :dv], sol[..., dv:]
    attn = jnp.einsum('bhncd,bhnsd->bhncs', qc, kc) * decay
    k_dec = kc * jnp.exp(gcum[..., -1:] - gcum)[..., None]
    q_dec = qc * jnp.exp(gcum)[..., None]
    g_last = jnp.exp(gcum[..., -1])
    xs = tuple(jnp.moveaxis(a, 2, 0) for a in (q_dec, k_dec, u_blk, w_blk, attn, g_last))

    def step(s, inp):
        qd, kd, ui, wi, at, gl = inp
        v_new = ui - jnp.einsum('bhcd,bhde->bhce', wi, s)
        o = jnp.einsum('bhcd,bhde->bhce', qd, s) + jnp.einsum('bhcs,bhse->bhce', at, v_new)
        s = s * gl[..., None, None] + jnp.einsum('bhcd,bhce->bhde', kd, v_new)
        return s, o

    s_fin, o = lax.scan(step, s0, xs)
    o = jnp.moveaxis(o, 0, 2).reshape(bsz, h, n * CHUNK, dv)[:, :, :t]
    return jnp.moveaxis(o, 1, 2), s_fin


def gdn_mixer(qkv, z, b_logit, a_logit, conv_tail, s0, conv_w, a_log, dt_bias, norm_g):
    bsz, t, _ = qkv.shape
    f32 = jnp.float32
    qkv_c, new_tail = causal_conv_silu(qkv, conv_tail, conv_w)
    q, k, v = jnp.split(qkv_c.astype(f32), 3, axis=-1)
    shp = (bsz, t, GDN_HEADS, GDN_HEAD_DIM)
    q = l2norm(q.reshape(shp)) * (GDN_HEAD_DIM ** -0.5)
    k = l2norm(k.reshape(shp))
    v = v.reshape(shp)
    beta = jax.nn.sigmoid(b_logit.astype(f32))
    g = -jnp.exp(a_log.astype(f32)) * jax.nn.softplus(a_logit.astype(f32) + dt_bias.astype(f32))
    o, s_fin = gated_delta_rule(q, k, v, g, beta, s0.astype(f32))
    o = o * lax.rsqrt(jnp.mean(jnp.square(o), -1, keepdims=True) + NORM_EPS)
    o = o * norm_g.astype(f32) * jax.nn.silu(z.astype(f32).reshape(shp))
    return o.reshape(bsz, t, GDN_WIDTH).astype(qkv.dtype), new_tail, s_fin.astype(s0.dtype)


def spatial_gating(u, v, ln_g, ln_b, w_s, b_s):
    bsz, t, _ = u.shape
    u = jax.nn.gelu(u, approximate=False)
    v = layer_norm(jax.nn.gelu(v, approximate=False), ln_g, ln_b)
    n = -(-t // SMLP_CHUNK)
    pad = n * SMLP_CHUNK - t
    vc = jnp.pad(v, ((0, 0), (0, pad), (0, 0))).reshape(bsz, n, SMLP_CHUNK, SMLP_GROUPS, SMLP_GROUP_DIM)
    w = jnp.where(jnp.tril(jnp.ones((SMLP_CHUNK, SMLP_CHUNK), bool)), w_s, 0.0)
    s = jnp.einsum('gpq,bnqgc->bnpgc', w, vc) + jnp.transpose(b_s)[None, None, :, :, None]
    s = s.reshape(bsz, n * SMLP_CHUNK, SMLP_WIDTH)[:, :t]
    return u * s, v


def trunk_layer(x, conv_tail, s0, w_in, conv_w, a_log, dt_bias, gdn_norm_g, smlp_ln_g, smlp_ln_b,
                w_s, b_s, w_out, ln1_g, ln1_b, w_up, w_down, ln2_g, ln2_b):
    h = jnp.einsum('btd,de->bte', x, w_in)
    qkv, z, b_logit, a_logit, u, v = jnp.split(h, SPLITS, axis=-1)
    y_a, new_tail, new_s = gdn_mixer(qkv, z, b_logit, a_logit, conv_tail, s0,
                                     conv_w, a_log, dt_bias, gdn_norm_g)
    y_b, v_rows = spatial_gating(u, v, smlp_ln_g, smlp_ln_b, w_s, b_s)
    mix = jnp.einsum('btm,md->btd', jnp.concatenate([y_a, y_b], axis=-1), w_out)
    x = layer_norm(DN_ALPHA * x + mix, ln1_g, ln1_b)
    hid = jnp.square(jax.nn.relu(jnp.einsum('btd,df->btf', x, w_up)))
    x = layer_norm(DN_ALPHA * x + jnp.einsum('btf,fd->btd', hid, w_down), ln2_g, ln2_b)
    return x, new_tail, new_s, v_rows


def setup_inputs(seed: int = 0) -> dict:
    key = jax.random.key(seed)
    ks = jax.random.split(key, 24)
    f32 = jnp.float32

    def nrm(k, shape, scale):
        return jax.random.normal(k, shape, f32) * scale

    dt = jnp.exp(jax.random.uniform(ks[9], (DEPTH, GDN_HEADS), f32, math.log(1e-3), math.log(1e-1)))
    return {
        'x_prompt': nrm(ks[0], (BATCH, SEQ, D_MODEL), 1.0),
        'x_sample': nrm(ks[1], (DEC_BATCH, DEC_SEQ, D_MODEL), 1.0),
        'cache_conv': nrm(ks[2], (DEPTH, DEC_BATCH, CONV_W - 1, QKV_WIDTH), 1.0),
        'state_delta': nrm(ks[3], (DEPTH, DEC_BATCH, GDN_HEADS, GDN_HEAD_DIM, GDN_HEAD_DIM), 0.1),
        'ln0_g': 1.0 + nrm(ks[4], (D_MODEL,), 0.05),
        'ln0_b': nrm(ks[5], (D_MODEL,), 0.02),
        'w_in': nrm(ks[6], (DEPTH, D_MODEL, IN_WIDTH), D_MODEL ** -0.5),
        'conv_w': nrm(ks[7], (DEPTH, CONV_W, QKV_WIDTH), CONV_W ** -0.5),
        'a_log': jnp.log(jax.random.uniform(ks[8], (DEPTH, GDN_HEADS), f32, 1.0, 16.0)),
        'dt_bias': dt + jnp.log(-jnp.expm1(-dt)),
        'gdn_norm_g': 1.0 + nrm(ks[10], (DEPTH, GDN_HEAD_DIM), 0.05),
        'smlp_ln_g': 1.0 + nrm(ks[11], (DEPTH, SMLP_WIDTH), 0.05),
        'smlp_ln_b': nrm(ks[12], (DEPTH, SMLP_WIDTH), 0.02),
        'w_s': nrm(ks[13], (DEPTH, SMLP_GROUPS, SMLP_CHUNK, SMLP_CHUNK), 0.5 * SMLP_CHUNK ** -0.5),
        'b_s': 1.0 + nrm(ks[14], (DEPTH, SMLP_GROUPS, SMLP_CHUNK), 0.01),
        'w_out': nrm(ks[15], (DEPTH, MIX_WIDTH, D_MODEL), DN_BETA * MIX_WIDTH ** -0.5),
        'ln1_g': 1.0 + nrm(ks[16], (DEPTH, D_MODEL), 0.05),
        'ln1_b': nrm(ks[17], (DEPTH, D_MODEL), 0.02),
        'w_up': nrm(ks[18], (DEPTH, D_MODEL, D_FF), D_MODEL ** -0.5),
        'w_down': nrm(ks[19], (DEPTH, D_FF, D_MODEL), DN_BETA * D_FF ** -0.5),
        'ln2_g': 1.0 + nrm(ks[20], (DEPTH, D_MODEL), 0.05),
        'ln2_b': nrm(ks[21], (DEPTH, D_MODEL), 0.02),
    }


def reference(x_prompt, x_sample, cache_conv, state_delta, ln0_g, ln0_b, w_in, conv_w, a_log,
              dt_bias, gdn_norm_g, smlp_ln_g, smlp_ln_b, w_s, b_s, w_out, ln1_g, ln1_b,
              w_up, w_down, ln2_g, ln2_b):
    xp = layer_norm(x_prompt, ln0_g, ln0_b)
    xs = layer_norm(x_sample, ln0_g, ln0_b)
    tail0 = jnp.zeros((x_prompt.shape[0], CONV_W - 1, QKV_WIDTH), x_prompt.dtype)
    s_zero = jnp.zeros((x_prompt.shape[0], GDN_HEADS, GDN_HEAD_DIM, GDN_HEAD_DIM), x_prompt.dtype)
    conv_p, delta_p, conv_s, delta_s, v_s = [], [], [], [], []
    for l in range(DEPTH):
        lw = (w_in[l], conv_w[l], a_log[l], dt_bias[l], gdn_norm_g[l], smlp_ln_g[l], smlp_ln_b[l],
              w_s[l], b_s[l], w_out[l], ln1_g[l], ln1_b[l], w_up[l], w_down[l], ln2_g[l], ln2_b[l])
        xp, tp, sp, _ = trunk_layer(xp, tail0, s_zero, *lw)
        xs, tsm, ssm, vsm = trunk_layer(xs, cache_conv[l], state_delta[l], *lw)
        conv_p.append(tp)
        delta_p.append(sp)
        conv_s.append(tsm)
        delta_s.append(ssm)
        v_s.append(vsm)
    return (xp, xs, jnp.stack(conv_p), jnp.stack(delta_p), jnp.stack(conv_s), jnp.stack(delta_s), jnp.stack(v_s))
```

```cpp
#include <hip/hip_runtime.h>
#include <hip/hip_cooperative_groups.h>
#include <cstdio>
#include <cstdint>
namespace cg = cooperative_groups;
#ifndef MK_MULTI
#define MK_MULTI 0
#endif
namespace pg8 {
#define PG8_LAS __attribute__((address_space(3)))
typedef unsigned short bf16_t;
typedef short bf16x8 __attribute__((ext_vector_type(8)));
typedef float f32x4 __attribute__((ext_vector_type(4)));
typedef unsigned u32x4 __attribute__((ext_vector_type(4)));
constexpr int BM = 256, BK = 64, HALF = 128, HTB = HALF * BK * 2  , STAGE_BYTES = 8 * HTB, NXCD = 8, WGM = 8;

__host__ __device__ __forceinline__ int lds_byte(int r, int c) { const int st = (r >> 4) * 2 + (c >> 5), rr = r & 15, cc = c & 31, ob = rr * 64 + cc * 2; return st * 1024 + (ob ^ (((ob >> 9) & 1) << 5)); }
__host__ __device__ __forceinline__ void stage_rc(int b, int& R, int& C) { const int st = b / 1024, sb = b % 1024, swz = sb ^ (((sb >> 9) & 1) << 5); R = (st >> 1) * 16 + swz / 64; C = (st & 1) * 32 + (swz % 64) / 2; }
__host__ __device__ __forceinline__ int perm32(int rho) { const int n = rho >> 4, i = rho & 15; return 8 * (i >> 2) + 4 * n + (i & 3); }

struct Unit { int pm, pn; };
struct Gemm { const bf16_t* A; const bf16_t* Bt; int M, N, K; };

struct StaticOrder {
    int nM, nN, nwg, G, c;
    __host__ __device__ void init(int M, int N, int G_, int c_) { nM = M / BM; nN = N / BM; nwg = nM * nN; G = G_; c = c_; }
    __host__ __device__ bool next(int i, Unit& u) const {
        const long L = (long)i * G + c; if (L >= nwg) return false;
        int wgid = (int)L; { const int q = nwg / NXCD, r = nwg % NXCD, xcd = wgid % NXCD, off = wgid / NXCD; wgid = (xcd < r ? xcd * (q + 1) : r * (q + 1) + (xcd - r) * q) + off; }
        const int nig = WGM * nN, gid = wgid / nig, fm = gid * WGM, gsz = (nM - fm) < WGM ? (nM - fm) : WGM;
        u.pm = fm + ((wgid % nig) % gsz); u.pn = (wgid % nig) / gsz; return true;
    }
    __device__ __forceinline__ void a_ready(const Unit&) const {}
    __device__ __forceinline__ void done(const Unit&) const {}
};
__device__ __forceinline__ unsigned cvt_pk_bf16(float lo, float hi) { unsigned r; asm volatile("v_cvt_pk_bf16_f32 %0, %1, %2" : "=v"(r) : "v"(lo), "v"(hi)); return r; }
template <class Epi, class Sched, bool STAMP = false>
__device__ __forceinline__ void gemm_phase(PG8_LAS unsigned char* lds, const Gemm g, const Sched& S, const Epi& E, unsigned long long* stamps) {
    int tid_ = threadIdx.x; asm volatile("" : "+v"(tid_)); const int tid = tid_, wid = __builtin_amdgcn_readfirstlane(tid >> 6), lane = tid & 63, wr = wid >> 2, wc = wid & 3, fr = lane & 15, fq = lane >> 4;
    const int K = g.K, nt = K / BK;
    int ts_lo = 0, ts_hi = 0, nts = 0; const unsigned long long rt_entry = STAMP ? (unsigned long long)wall_clock64() : 0ull;
#define PG8_STAMP() do { if (STAMP && wid == 0 && nts < 64) { const unsigned long long _c = (unsigned long long)clock64(); \
        ts_lo = (lane == nts) ? (int)(unsigned)_c : ts_lo; ts_hi = (lane == nts) ? (int)(unsigned)(_c >> 32) : ts_hi; ++nts; } } while (0)
    PG8_STAMP();
    unsigned voffA[2], voffB[2];
#pragma unroll
    for (int i = 0; i < 2; ++i) { int R, C; stage_rc(tid * 16 + i * 8192, R, C); const int Rb = Epi::PERM ? ((R & ~31) + perm32(R & 31)) : R;
        voffA[i] = (unsigned)(R * K + C) * 2u; voffB[i] = (unsigned)(Rb * K + C) * 2u; }
    const size_t kstep = (size_t)(BK * 2);
    const size_t hstep = (size_t)HALF * K * 2;
    const size_t tstep = 2 * hstep;
    const unsigned ldsw = (unsigned)wid * 1024u;
    const int aoff = lds_byte(wr * 64 + fr, fq * 8), boff = lds_byte(wc * 32 + fr, fq * 8);
#define PG8_SA(b, h) (((b) * 2 + (h)) * HTB)
#define PG8_SB(b, h) ((4 + (b) * 2 + (h)) * HTB)
#define PG8_STAGE(bufoff, gbase, voff) do { _Pragma("unroll") for (int _i = 0; _i < 2; ++_i) \
        __builtin_amdgcn_global_load_lds((const unsigned*)((const char*)(gbase) + (voff)[_i]), (PG8_LAS unsigned*)(lds + (bufoff) + ldsw + _i * 8192), 16, 0, 0); } while (0)
#define PG8_LDA(dst, b, h) do { _Pragma("unroll") for (int m = 0; m < 4; ++m) _Pragma("unroll") for (int k = 0; k < 2; ++k) dst[m][k] = *(const PG8_LAS bf16x8*)(lds + PG8_SA(b, h) + aoff + m * 2048 + k * 1024); } while (0)
#define PG8_LDB(dst, b, h) do { _Pragma("unroll") for (int n = 0; n < 2; ++n) _Pragma("unroll") for (int k = 0; k < 2; ++k) dst[n][k] = *(const PG8_LAS bf16x8*)(lds + PG8_SB(b, h) + boff + n * 2048 + k * 1024); } while (0)
#define PG8_MMA(ai, bj, At, Bt) do { __builtin_amdgcn_s_setprio(1); _Pragma("unroll") for (int m = 0; m < 4; ++m) _Pragma("unroll") for (int n = 0; n < 2; ++n) _Pragma("unroll") for (int k = 0; k < 2; ++k) \
        acc[ai][bj][m][n] = __builtin_amdgcn_mfma_f32_16x16x32_bf16(Bt[n][k], At[m][k], acc[ai][bj][m][n], 0, 0, 0); __builtin_amdgcn_s_setprio(0); } while (0)
#define PG8_WAIT_V(n) asm volatile("s_waitcnt vmcnt(" #n ")" ::: "memory")
#define PG8_WAIT_L(n) asm volatile("s_waitcnt lgkmcnt(" #n ")" ::: "memory")
#define PG8_BAR __builtin_amdgcn_s_barrier()
#define PG8_SCHED __builtin_amdgcn_sched_barrier(0)
    Unit cur, nxt; int ui = 0;
    if (!S.next(0, cur)) return;
    f32x4 acc[2][2][4][2];
#pragma unroll
    for (int a = 0; a < 2; ++a)
#pragma unroll
        for (int b = 0; b < 2; ++b)
#pragma unroll
            for (int m = 0; m < 4; ++m)
#pragma unroll
                for (int n = 0; n < 2; ++n) acc[a][b][m][n] = (f32x4){0.f, 0.f, 0.f, 0.f};
    bf16x8 At[4][2], B0[2][2], B1[2][2];
    const char* cA = (const char*)g.A + (size_t)cur.pm * tstep; const char* cB = (const char*)g.Bt + (size_t)cur.pn * tstep;
    S.a_ready(cur);
    PG8_STAGE(PG8_SB(0, 0), cB, voffB); PG8_STAGE(PG8_SA(0, 0), cA, voffA); PG8_STAGE(PG8_SB(0, 1), cB + hstep, voffB); PG8_STAGE(PG8_SA(0, 1), cA + hstep, voffA);
    if (wr == 1) PG8_BAR;
    PG8_WAIT_V(4); PG8_BAR;
    PG8_STAGE(PG8_SB(1, 0), cB + kstep, voffB); PG8_STAGE(PG8_SA(1, 0), cA + kstep, voffA); PG8_STAGE(PG8_SB(1, 1), cB + hstep + kstep, voffB);
    PG8_WAIT_V(6); PG8_BAR;
    PG8_STAMP();
    for (;;) {
        const bool has_next = S.next(ui + 1, nxt);
        const char* nA = has_next ? (const char*)g.A + (size_t)nxt.pm * tstep : cA; const char* nB = has_next ? (const char*)g.Bt + (size_t)nxt.pn * tstep : cB;
        for (int t = 0; t < nt; t += 2) {
            const bool last = (t == nt - 2);
            const char* a1 = cA + (size_t)(t + 1) * kstep;
            const char* a2 = last ? nA : cA + (size_t)(t + 2) * kstep; const char* b2 = last ? nB : cB + (size_t)(t + 2) * kstep;
            const char* a3 = a2 + kstep; const char* b3 = b2 + kstep;
            if (last && has_next) S.a_ready(nxt);
            PG8_LDB(B0, 0, 0); PG8_SCHED; PG8_LDA(At, 0, 0); PG8_STAGE(PG8_SA(1, 1), a1 + hstep, voffA);
            PG8_WAIT_L(8); PG8_BAR; PG8_WAIT_L(0); PG8_MMA(0, 0, At, B0); PG8_BAR; PG8_SCHED;
            PG8_LDB(B1, 0, 1); PG8_STAGE(PG8_SB(0, 0), b2, voffB);
            PG8_BAR; PG8_WAIT_L(0); PG8_MMA(0, 1, At, B1); PG8_BAR;
            PG8_LDA(At, 0, 1); PG8_STAGE(PG8_SA(0, 0), a2, voffA);
            PG8_BAR; PG8_WAIT_L(0); PG8_MMA(1, 0, At, B0); PG8_BAR; PG8_SCHED;
            PG8_STAGE(PG8_SB(0, 1), b2 + hstep, voffB);
            PG8_WAIT_V(6); PG8_BAR; PG8_MMA(1, 1, At, B1); PG8_BAR;
            PG8_LDB(B0, 1, 0); PG8_SCHED; PG8_LDA(At, 1, 0); PG8_STAGE(PG8_SA(0, 1), a2 + hstep, voffA);
            PG8_WAIT_L(8); PG8_BAR; PG8_WAIT_L(0); PG8_MMA(0, 0, At, B0); PG8_BAR; PG8_SCHED;
            PG8_LDB(B1, 1, 1); PG8_STAGE(PG8_SB(1, 0), b3, voffB);
            PG8_BAR; PG8_WAIT_L(0); PG8_MMA(0, 1, At, B1); PG8_BAR;
            PG8_LDA(At, 1, 1); PG8_STAGE(PG8_SA(1, 0), a3, voffA);
            PG8_BAR; PG8_WAIT_L(0); PG8_MMA(1, 0, At, B0); PG8_BAR; PG8_SCHED;
            PG8_STAGE(PG8_SB(1, 1), b3 + hstep, voffB);
            PG8_WAIT_V(6); PG8_BAR; PG8_MMA(1, 1, At, B1); PG8_BAR;
        }
        PG8_STAMP();
        if constexpr (!Epi::AFTER_DRAIN) { E(acc, cur, wr, wc, fr, fq); S.done(cur); }
        PG8_STAMP();
        if (!has_next) break;
#pragma unroll
        for (int a = 0; a < 2; ++a)
#pragma unroll
            for (int b = 0; b < 2; ++b)
#pragma unroll
                for (int m = 0; m < 4; ++m)
#pragma unroll
                    for (int n = 0; n < 2; ++n) acc[a][b][m][n] = (f32x4){0.f, 0.f, 0.f, 0.f};
        cur = nxt; cA = nA; cB = nB; ++ui;
    }
    PG8_WAIT_V(0);
    if (wr == 0) PG8_BAR;
    PG8_BAR;
    if constexpr (Epi::AFTER_DRAIN) { E.fused(acc, cur, wr, wc, fr, fq, lds, wid, lane); S.done(cur); }
    PG8_STAMP();
    if (STAMP && wid == 0) { stamps[lane] = lane < nts ? (((unsigned long long)(unsigned)ts_hi << 32) | (unsigned)ts_lo) : 0ull;
        if (lane == 62) stamps[62] = rt_entry; if (lane == 63) stamps[63] = (unsigned long long)wall_clock64(); }
#undef PG8_STAMP
#undef PG8_SA
#undef PG8_SB
#undef PG8_STAGE
#undef PG8_LDA
#undef PG8_LDB
#undef PG8_MMA
#undef PG8_WAIT_V
#undef PG8_WAIT_L
#undef PG8_BAR
#undef PG8_SCHED
}
}

using pg8::bf16_t; using pg8::bf16x8; using pg8::f32x4; using pg8::u32x4;

constexpr int DM = 1024, NTOK = 66048, NPROMPT = 65536, INW = 3080, HW = 3072, DFF = 4096;
constexpr int NITEM = 4128;
constexpr float DN_ALPHA = 1.4142135623730951f;
constexpr size_t WS_WIN = 0, WS_WOUT = 12582912, WS_WUP = 16777216, WS_WDN = 33554432, WS_XB = 50331648, WS_LOG = 185597952,
                 WS_ATT = 187711488, WS_GL = 221528064, WS_BIG = 221593600, WS_Y = WS_BIG + 405798912, WS_END = WS_BIG + 541065216;
constexpr size_t O_YS = 67108864, O_CONVP = 67633152, O_DELTAP = 67780608, O_CONVS = 69877760, O_DELTAS = 69951488, O_SMLPV = 71000064;
constexpr int LDS_BYTES = 149504;
constexpr int NPHASE = 17;

struct Args { const float* in[22]; float* out; unsigned char* ws; int ph_lo, ph_hi; };
enum { I_XP = 0, I_XS, I_CCONV, I_SDELTA, I_LN0G, I_LN0B, I_WIN, I_CONVW, I_ALOG, I_DTB, I_GNG, I_SLNG, I_SLNB, I_WS, I_BS, I_WOUT, I_LN1G, I_LN1B, I_WUP, I_WDN, I_LN2G, I_LN2B };

__device__ __forceinline__ int opaque_v(int x) { asm volatile("" : "+v"(x)); return x; }
__device__ __forceinline__ int opaque_s(int x) { asm volatile("" : "+s"(x)); return x; }
__device__ __forceinline__ float bf2f(unsigned short b) { return __uint_as_float((unsigned)b << 16); }
__device__ __forceinline__ unsigned pk2(float lo, float hi) { return pg8::cvt_pk_bf16(lo, hi); }
__device__ __forceinline__ unsigned short f2bf(float f) { return (unsigned short)(pk2(f, 0.f) & 0xffffu); }
__device__ __forceinline__ void unpack8(const uint4 v, float* o) {
    o[0] = __uint_as_float(v.x << 16); o[1] = __uint_as_float(v.x & 0xffff0000u); o[2] = __uint_as_float(v.y << 16); o[3] = __uint_as_float(v.y & 0xffff0000u);
    o[4] = __uint_as_float(v.z << 16); o[5] = __uint_as_float(v.z & 0xffff0000u); o[6] = __uint_as_float(v.w << 16); o[7] = __uint_as_float(v.w & 0xffff0000u);
}
__device__ __forceinline__ uint4 pack8(const float* x) { uint4 r; r.x = pk2(x[0], x[1]); r.y = pk2(x[2], x[3]); r.z = pk2(x[4], x[5]); r.w = pk2(x[6], x[7]); return r; }
__device__ __forceinline__ uint2 pack4(const f32x4 v) { uint2 r; r.x = pk2(v[0], v[1]); r.y = pk2(v[2], v[3]); return r; }
__device__ __forceinline__ float wave_sum(float v) {
#pragma unroll
    for (int o = 32; o; o >>= 1) v += __shfl_xor(v, o);
    return v;
}
__device__ __forceinline__ float gelu_f(float x) { return 0.5f * x * (1.0f + erff(x * 0.70710678118654752f)); }
__device__ __forceinline__ f32x4 mfma16(const bf16x8 a, const bf16x8 b, const f32x4 c) { return __builtin_amdgcn_mfma_f32_16x16x32_bf16(a, b, c, 0, 0, 0); }

struct EpiAct {
    static constexpr bool PERM = true, AFTER_DRAIN = false;
    bf16_t* O; int ldc; int act;
    __device__ __forceinline__ void operator()(const f32x4 (&acc)[2][2][4][2], const pg8::Unit& u, int wr, int wc, int fr, int fq) const {
        const int row0 = u.pm * 256 + wr * 64 + fr, col0 = u.pn * 256 + wc * 32 + 8 * fq;
#pragma unroll
        for (int ai = 0; ai < 2; ++ai)
#pragma unroll
            for (int m = 0; m < 4; ++m) { bf16_t* rowp = O + (size_t)(row0 + ai * 128 + m * 16) * ldc + col0;
#pragma unroll
                for (int bj = 0; bj < 2; ++bj) { f32x4 v0 = acc[ai][bj][m][0], v1 = acc[ai][bj][m][1];
                    if (act) {
#pragma unroll
                        for (int j = 0; j < 4; ++j) { float p = fmaxf(v0[j], 0.f), q = fmaxf(v1[j], 0.f); v0[j] = p * p; v1[j] = q * q; } }
                    u32x4 w; w.x = pk2(v0[0], v0[1]); w.y = pk2(v0[2], v0[3]); w.z = pk2(v1[0], v1[1]); w.w = pk2(v1[2], v1[3]);
                    *(u32x4*)(rowp + bj * 128) = w; } }
    }
};
struct EpiRes {
    static constexpr bool PERM = false, AFTER_DRAIN = false;
    float* C; const bf16_t* X;
    __device__ __forceinline__ void operator()(const f32x4 (&acc)[2][2][4][2], const pg8::Unit& u, int wr, int wc, int fr, int fq) const {
        const int row0 = u.pm * 256 + wr * 64 + fr, col0 = u.pn * 256 + wc * 32 + 4 * fq;
#pragma unroll
        for (int ai = 0; ai < 2; ++ai)
#pragma unroll
            for (int m = 0; m < 4; ++m) { const size_t ro = (size_t)(row0 + ai * 128 + m * 16) * DM + col0;
#pragma unroll
                for (int bj = 0; bj < 2; ++bj)
#pragma unroll
                    for (int n = 0; n < 2; ++n) { const size_t o = ro + bj * 128 + n * 16; const uint2 xv = *(const uint2*)(X + o);
                        f32x4 r = acc[ai][bj][m][n];
                        r[0] += DN_ALPHA * __uint_as_float(xv.x << 16); r[1] += DN_ALPHA * __uint_as_float(xv.x & 0xffff0000u);
                        r[2] += DN_ALPHA * __uint_as_float(xv.y << 16); r[3] += DN_ALPHA * __uint_as_float(xv.y & 0xffff0000u);
                        *(f32x4*)(C + o) = r; }
                __builtin_amdgcn_sched_barrier(0); }
    }
};

__device__ __forceinline__ void transpose_tile(const float* __restrict__ src, int ld_src, bf16_t* __restrict__ dst, int ld_dst, int k0, int n0s, int n0d, float* tile) {
    const int tidt = opaque_v(threadIdx.x); const int tx = tidt & 63, ty = tidt >> 6;
#pragma unroll
    for (int i = 0; i < 8; ++i) { const int k = ty + 8 * i; tile[k * 65 + tx] = src[(size_t)(k0 + k) * ld_src + n0s + tx]; }
    __syncthreads();
#pragma unroll
    for (int i = 0; i < 8; ++i) { const int n = ty + 8 * i; dst[(size_t)(n0d + n) * ld_dst + k0 + tx] = f2bf(tile[tx * 65 + n]); }
    __syncthreads();
}
__device__ __forceinline__ void weights_phase(const Args& a, unsigned char* lds) {
    float* tile = (float*)lds;
    for (int t = opaque_s(blockIdx.x); t < 6144; t += gridDim.x) {
        if (t < 1536) { const int l = t / 768, r = t % 768, kt = r / 48, nt = r % 48; const int n0d = nt * 64, n0s = n0d < 2048 ? n0d : n0d + 8;
            transpose_tile(a.in[I_WIN] + (size_t)l * DM * INW, INW, (bf16_t*)(a.ws + WS_WIN) + (size_t)l * HW * DM, DM, kt * 64, n0s, n0d, tile); }
        else if (t < 2048) { const int q = t - 1536, l = q / 256, r = q % 256, kt = r / 16, nt = r % 16;
            transpose_tile(a.in[I_WOUT] + (size_t)l * DM * DM, DM, (bf16_t*)(a.ws + WS_WOUT) + (size_t)l * DM * DM, DM, kt * 64, nt * 64, nt * 64, tile); }
        else if (t < 4096) { const int q = t - 2048, l = q / 1024, r = q % 1024, kt = r / 64, nt = r % 64;
            transpose_tile(a.in[I_WUP] + (size_t)l * DM * DFF, DFF, (bf16_t*)(a.ws + WS_WUP) + (size_t)l * DFF * DM, DM, kt * 64, nt * 64, nt * 64, tile); }
        else { const int q = t - 4096, l = q / 1024, r = q % 1024, kt = r / 16, nt = r % 16;
            transpose_tile(a.in[I_WDN] + (size_t)l * DFF * DM, DM, (bf16_t*)(a.ws + WS_WDN) + (size_t)l * DM * DFF, DFF, kt * 64, nt * 64, nt * 64, tile); }
    }
}

__device__ __forceinline__ void ln_phase(const Args& a, unsigned char* lds, const float* srcP, const float* srcS, const float* __restrict__ g, const float* __restrict__ b,
                                         bool f32out, float* dstP, float* dstS, bool logits, int lnext) {
    const int tid = opaque_v(threadIdx.x), lane = tid & 63, wid = tid >> 6;
    float* wl = (float*)lds;
    if (logits) {
        const float* w = a.in[I_WIN] + (size_t)lnext * DM * INW;
        for (int i = tid; i < 8192; i += 512) { const int k = i >> 3, j = i & 7; wl[j * 1024 + k] = w[(size_t)k * INW + 2048 + j]; }
        __syncthreads();
    }
    bf16_t* xb = (bf16_t*)(a.ws + WS_XB); float* LOG = (float*)(a.ws + WS_LOG);
    float4 gv[4], bv[4];
#pragma unroll
    for (int i = 0; i < 4; ++i) { gv[i] = *(const float4*)(g + i * 256 + lane * 4); bv[i] = *(const float4*)(b + i * 256 + lane * 4); }
    for (int row = opaque_s(blockIdx.x) * 8 + wid; row < NTOK; row += gridDim.x * 8) {
        const float* src = row < NPROMPT ? srcP + (size_t)row * DM : srcS + (size_t)(row - NPROMPT) * DM;
        float4 v[4];
#pragma unroll
        for (int i = 0; i < 4; ++i) v[i] = *(const float4*)(src + i * 256 + lane * 4);
        float s = 0.f;
#pragma unroll
        for (int i = 0; i < 4; ++i) s += (v[i].x + v[i].y) + (v[i].z + v[i].w);
        const float mean = wave_sum(s) * (1.0f / 1024.0f);
        float q = 0.f;
#pragma unroll
        for (int i = 0; i < 4; ++i) { v[i].x -= mean; v[i].y -= mean; v[i].z -= mean; v[i].w -= mean; q += (v[i].x * v[i].x + v[i].y * v[i].y) + (v[i].z * v[i].z + v[i].w * v[i].w); }
        const float rstd = rsqrtf(wave_sum(q) * (1.0f / 1024.0f) + 1e-5f);
#pragma unroll
        for (int i = 0; i < 4; ++i) { v[i].x = v[i].x * rstd * gv[i].x + bv[i].x; v[i].y = v[i].y * rstd * gv[i].y + bv[i].y; v[i].z = v[i].z * rstd * gv[i].z + bv[i].z; v[i].w = v[i].w * rstd * gv[i].w + bv[i].w; }
#pragma unroll
        for (int i = 0; i < 4; ++i) { uint2 p; p.x = pk2(v[i].x, v[i].y); p.y = pk2(v[i].z, v[i].w); *(uint2*)(xb + (size_t)row * DM + i * 256 + lane * 4) = p; }
        if (f32out) { float* dst = row < NPROMPT ? dstP + (size_t)row * DM : dstS + (size_t)(row - NPROMPT) * DM;
#pragma unroll
            for (int i = 0; i < 4; ++i) *(float4*)(dst + i * 256 + lane * 4) = v[i]; }
        if (logits) {
            float myv = 0.f;
#pragma unroll
            for (int j = 0; j < 8; ++j) { float p = 0.f;
#pragma unroll
                for (int i = 0; i < 4; ++i) { const float4 w = *(const float4*)(wl + j * 1024 + i * 256 + lane * 4); p += (v[i].x * w.x + v[i].y * w.y) + (v[i].z * w.z + v[i].w * w.w); }
                p = wave_sum(p); if (lane == j) myv = p; }
            if (lane < 8) LOG[(size_t)row * 8 + lane] = myv;
        }
    }
    __syncthreads();
}

__device__ __forceinline__ void gdn_prep_item(const Args& a, unsigned char* lds, int l, int item) {
    const int tid = opaque_v(threadIdx.x), lane = tid & 63, wid = tid >> 6, lr = lane & 15, lq = lane >> 4;
    const int c64 = item >> 2, h = item & 3, tok0 = c64 * 64;
    const bool sample = c64 >= 1024;
    const int mode = sample ? 2 : ((c64 & 63) == 0 ? 0 : 1);
    const bf16_t* H = (const bf16_t*)(a.ws + WS_BIG);
    const float* LOG = (const float*)(a.ws + WS_LOG);
    float* Am = (float*)(lds); bf16_t* Ts = (bf16_t*)(lds + 17408); float* gcs = (float*)(lds + 26624); float* bts = gcs + 64;
    bf16_t* Ks = (bf16_t*)(lds + 27136); bf16_t* Qs = (bf16_t*)(lds + 44544); bf16_t* VBs = (bf16_t*)(lds + 61952); bf16_t* KGs = (bf16_t*)(lds + 79360);
    unsigned char* ib = (unsigned char*)a.out + (size_t)item * 65536;
    bf16_t* NW = (bf16_t*)ib; bf16_t* UF = (bf16_t*)(ib + 16384); bf16_t* QD = (bf16_t*)(ib + 32768); bf16_t* KDT = (bf16_t*)(ib + 49152);
    bf16_t* ATT = (bf16_t*)(a.ws + WS_ATT) + (size_t)item * 4096;
    if (wid == 0) {
        const float* lg = LOG + (size_t)(tok0 + lane) * 8;
        const float bl = lg[h], al = lg[4 + h];
        const float A = expf(a.in[I_ALOG][l * 4 + h]); const float x = al + a.in[I_DTB][l * 4 + h];
        const float sp = x > 20.f ? x : log1pf(expf(x));
        float g = -A * sp;
#pragma unroll
        for (int o = 1; o < 64; o <<= 1) { const float t = __shfl_up(g, o); if (lane >= o) g += t; }
        gcs[lane] = g; bts[lane] = 1.0f / (1.0f + expf(-bl));
        if (lane == 63) ((float*)(a.ws + WS_GL))[item] = expf(g);
    }
    __syncthreads();
    {
        const int r = tid >> 3, cgi = tid & 7;
        const float gc = gcs[r], bt = bts[r], gl = gcs[63];
        const float eg = expf(gc), egl = expf(gl - gc);
        const float* convw = a.in[I_CONVW] + (size_t)l * 4 * 1536;
        const float* cc = a.in[I_CCONV] + (size_t)(l * 8 + (sample ? c64 - 1024 : 0)) * 3 * 1536;
#pragma unroll 1
        for (int which = 0; which < 3; ++which) {
            const int col = which * 512 + h * 128 + cgi * 16;
            float acc[16];
#pragma unroll
            for (int i = 0; i < 16; ++i) acc[i] = 0.f;
#pragma unroll
            for (int j = 0; j < 4; ++j) {
                const int rr = r + j - 3;
                float x[16];
                if (rr >= 0 || mode == 1) { const uint4* p = (const uint4*)(H + (ptrdiff_t)(tok0 + rr) * HW + col); const uint4 v0 = p[0], v1 = p[1]; unpack8(v0, x); unpack8(v1, x + 8); }
                else if (mode == 2) { const float4* p = (const float4*)(cc + (size_t)(rr + 3) * 1536 + col);
#pragma unroll
                    for (int i = 0; i < 4; ++i) { const float4 t = p[i]; x[4 * i] = t.x; x[4 * i + 1] = t.y; x[4 * i + 2] = t.z; x[4 * i + 3] = t.w; } }
                else {
#pragma unroll
                    for (int i = 0; i < 16; ++i) x[i] = 0.f; }
                const float4* wp = (const float4*)(convw + (size_t)j * 1536 + col);
#pragma unroll
                for (int i = 0; i < 4; ++i) { const float4 w = wp[i]; acc[4 * i] += x[4 * i] * w.x; acc[4 * i + 1] += x[4 * i + 1] * w.y; acc[4 * i + 2] += x[4 * i + 2] * w.z; acc[4 * i + 3] += x[4 * i + 3] * w.w; }
            }
#pragma unroll
            for (int i = 0; i < 16; ++i) acc[i] = acc[i] / (1.0f + expf(-acc[i]));
            if (which < 2) {
                float ss = 0.f;
#pragma unroll
                for (int i = 0; i < 16; ++i) ss += acc[i] * acc[i];
                ss += __shfl_xor(ss, 1); ss += __shfl_xor(ss, 2); ss += __shfl_xor(ss, 4);
                const float sc = rsqrtf(ss + 1e-6f) * (which == 0 ? 0.08838834764831845f : 1.0f);
#pragma unroll
                for (int i = 0; i < 16; ++i) acc[i] *= sc;
            }
            float t[16];
            if (which == 0) {
                *(uint4*)(Qs + r * 136 + cgi * 16) = pack8(acc); *(uint4*)(Qs + r * 136 + cgi * 16 + 8) = pack8(acc + 8);
#pragma unroll
                for (int i = 0; i < 16; ++i) t[i] = acc[i] * eg;
                *(uint4*)(QD + r * 128 + cgi * 16) = pack8(t); *(uint4*)(QD + r * 128 + cgi * 16 + 8) = pack8(t + 8);
            } else if (which == 1) {
                *(uint4*)(Ks + r * 136 + cgi * 16) = pack8(acc); *(uint4*)(Ks + r * 136 + cgi * 16 + 8) = pack8(acc + 8);
                const float f = bt * eg;
#pragma unroll
                for (int i = 0; i < 16; ++i) t[i] = acc[i] * f;
                *(uint4*)(KGs + r * 136 + cgi * 16) = pack8(t); *(uint4*)(KGs + r * 136 + cgi * 16 + 8) = pack8(t + 8);
#pragma unroll
                for (int i = 0; i < 16; ++i) KDT[(cgi * 16 + i) * 64 + r] = f2bf(acc[i] * egl);
            } else {
#pragma unroll
                for (int i = 0; i < 16; ++i) t[i] = acc[i] * bt;
                *(uint4*)(VBs + r * 136 + cgi * 16) = pack8(t); *(uint4*)(VBs + r * 136 + cgi * 16 + 8) = pack8(t + 8);
            }
        }
    }
    __syncthreads();
#pragma unroll
    for (int tt = 0; tt < 4; ++tt) {
        const int t = wid * 4 + tt, which = t >> 4, it = (t >> 2) & 3, jt = t & 3;
        f32x4 c = {0.f, 0.f, 0.f, 0.f};
        if (jt <= it) {
            const bf16_t* As = which ? Qs : Ks;
#pragma unroll
            for (int ks = 0; ks < 4; ++ks) {
                const bf16x8 af = *(const bf16x8*)(As + (16 * it + lr) * 136 + 32 * ks + 8 * lq);
                const bf16x8 bf = *(const bf16x8*)(Ks + (16 * jt + lr) * 136 + 32 * ks + 8 * lq);
                c = mfma16(af, bf, c);
            }
        }
        const int j = 16 * jt + lr; const float gj = gcs[j];
#pragma unroll
        for (int x = 0; x < 4; ++x) {
            const int i = 16 * it + 4 * lq + x;
            if (which == 0) { const float val = (i > j) ? bts[i] * c[x] * expf(gcs[i] - gj) : 0.f; Am[i * 68 + j] = val; }
            else { const float val = (i >= j) ? c[x] * expf(gcs[i] - gj) : 0.f; ATT[i * 64 + j] = f2bf(val); }
        }
    }
    __syncthreads();
    if (wid == 0) {
        float t[64]; const float lanef = (float)lane;
#pragma unroll
        for (int i = 0; i < 64; ++i) t[i] = 0.f;
#pragma unroll
        for (int i = 0; i < 64; ++i) {
            float s = fmaxf(0.0f, 1.0f - fabsf(lanef - (float)i));
#pragma unroll
            for (int jq = 0; jq < (i + 3) / 4; ++jq) {
                const float4 a4 = *(const float4*)(Am + i * 68 + 4 * jq);
                s -= a4.x * t[4 * jq]; s -= a4.y * t[4 * jq + 1]; s -= a4.z * t[4 * jq + 2]; s -= a4.w * t[4 * jq + 3];
            }
            t[i] = s;
            Ts[i * 72 + lane] = f2bf(s);
        }
    }
    __syncthreads();
#pragma unroll
    for (int mat = 0; mat < 2; ++mat) {
        const bf16_t* X = mat ? KGs : VBs;
        f32x4 c[4];
#pragma unroll
        for (int rt = 0; rt < 4; ++rt) c[rt] = (f32x4){0.f, 0.f, 0.f, 0.f};
#pragma unroll
        for (int ks = 0; ks < 2; ++ks) {
            bf16x8 bf;
#pragma unroll
            for (int jj = 0; jj < 8; ++jj) bf[jj] = (short)X[(32 * ks + 8 * lq + jj) * 136 + 16 * wid + lr];
#pragma unroll
            for (int rt = 0; rt < 4; ++rt) { const bf16x8 af = *(const bf16x8*)(Ts + (16 * rt + lr) * 72 + 32 * ks + 8 * lq); c[rt] = mfma16(af, bf, c[rt]); }
        }
        if (mat == 0) {
#pragma unroll
            for (int rt = 0; rt < 4; ++rt) *(uint2*)(UF + ((rt * 8 + wid) * 64 + lane) * 4) = pack4(c[rt]);
        } else {
#pragma unroll
            for (int rt = 0; rt < 4; ++rt)
#pragma unroll
                for (int x = 0; x < 4; ++x) NW[(16 * rt + 4 * lq + x) * 128 + 16 * wid + lr] = f2bf(-c[rt][x]);
        }
    }
    __syncthreads();
}

__device__ __forceinline__ void prep_phase(const Args& a, unsigned char* lds, int l) {
    l = opaque_s(l);
    for (int item = opaque_s(blockIdx.x); item < NITEM; item += gridDim.x) gdn_prep_item(a, lds, l, item);
    const bf16_t* H = (const bf16_t*)(a.ws + WS_BIG);
    for (int i = opaque_s(blockIdx.x) * 512 + opaque_v(threadIdx.x); i < 24 * 3 * 1536; i += gridDim.x * 512) {
        const int col = i % 1536, j = (i / 1536) % 3, s = i / 4608;
        if (s < 16) a.out[O_CONVP + ((size_t)(l * 16 + s) * 3 + j) * 1536 + col] = bf2f(H[(size_t)(s * 4096 + 4093 + j) * HW + col]);
        else a.out[O_CONVS + ((size_t)(l * 8 + (s - 16)) * 3 + j) * 1536 + col] = bf2f(H[(size_t)(NPROMPT + (s - 16) * 64 + 61 + j) * HW + col]);
    }
}

__device__ __forceinline__ void scan_item(const Args& a, unsigned char* lds, int l, int sidx) {
    const int tid = opaque_v(threadIdx.x), lane = tid & 63, wid = tid >> 6, lr = lane & 15, lq = lane >> 4;
    const bool sample = sidx >= 64;
    const int b = sample ? (sidx - 64) >> 2 : sidx >> 2, h = sidx & 3, nch = sample ? 1 : 64, c64_0 = sample ? 1024 + b : b * 64;
    bf16_t* ST = (bf16_t*)lds; bf16_t* VNT = (bf16_t*)(lds + 34816); bf16_t* NWs = (bf16_t*)(lds + 53248); bf16_t* QDs = (bf16_t*)(lds + 70656);
    bf16_t* KDTs = (bf16_t*)(lds + 88064); bf16_t* ATs = (bf16_t*)(lds + 106496); float* OB = (float*)(lds + 115712);
    const bf16_t* H = (const bf16_t*)(a.ws + WS_BIG); bf16_t* Y = (bf16_t*)(a.ws + WS_Y);
    const float* GL = (const float*)(a.ws + WS_GL);
    f32x4 aS[8];
    if (sample) {
        const float* s0 = a.in[I_SDELTA] + (size_t)((l * 8 + b) * 4 + h) * 16384;
#pragma unroll
        for (int dt = 0; dt < 8; ++dt) {
#pragma unroll
            for (int x = 0; x < 4; ++x) aS[dt][x] = s0[(16 * dt + 4 * lq + x) * 128 + 16 * wid + lr];
            *(uint2*)(ST + (16 * wid + lr) * 136 + 16 * dt + 4 * lq) = pack4(aS[dt]);
        }
    } else {
#pragma unroll
        for (int dt = 0; dt < 8; ++dt) { aS[dt] = (f32x4){0.f, 0.f, 0.f, 0.f}; *(uint2*)(ST + (16 * wid + lr) * 136 + 16 * dt + 4 * lq) = make_uint2(0u, 0u); }
    }
    uint4 pf0, pf1, pf2, pf3, pf4, pf5, pf6; uint2 uf0, uf1, uf2, uf3; float gl;
#define SCAN_LOAD(ITEM) do { const unsigned char* ib_ = (const unsigned char*)a.out + (size_t)(ITEM) * 65536; \
        pf0 = *(const uint4*)(ib_ + (size_t)tid * 16); pf1 = *(const uint4*)(ib_ + (size_t)(tid + 512) * 16); \
        pf2 = *(const uint4*)(ib_ + 32768 + (size_t)tid * 16); pf3 = *(const uint4*)(ib_ + 32768 + (size_t)(tid + 512) * 16); \
        pf4 = *(const uint4*)(ib_ + 49152 + (size_t)tid * 16); pf5 = *(const uint4*)(ib_ + 49152 + (size_t)(tid + 512) * 16); \
        pf6 = *(const uint4*)((const unsigned char*)(a.ws + WS_ATT) + (size_t)(ITEM) * 8192 + (size_t)tid * 16); \
        uf0 = *(const uint2*)(ib_ + 16384 + (size_t)((0 * 8 + wid) * 64 + lane) * 8); \
        uf1 = *(const uint2*)(ib_ + 16384 + (size_t)((1 * 8 + wid) * 64 + lane) * 8); \
        uf2 = *(const uint2*)(ib_ + 16384 + (size_t)((2 * 8 + wid) * 64 + lane) * 8); \
        uf3 = *(const uint2*)(ib_ + 16384 + (size_t)((3 * 8 + wid) * 64 + lane) * 8); \
        gl = GL[ITEM]; } while (0)
#define SCAN_STORE() do { \
        *(uint4*)((unsigned char*)NWs + (tid >> 4) * 272 + (tid & 15) * 16) = pf0; *(uint4*)((unsigned char*)NWs + ((tid + 512) >> 4) * 272 + (tid & 15) * 16) = pf1; \
        *(uint4*)((unsigned char*)QDs + (tid >> 4) * 272 + (tid & 15) * 16) = pf2; *(uint4*)((unsigned char*)QDs + ((tid + 512) >> 4) * 272 + (tid & 15) * 16) = pf3; \
        *(uint4*)((unsigned char*)KDTs + (tid >> 3) * 144 + (tid & 7) * 16) = pf4; *(uint4*)((unsigned char*)KDTs + ((tid + 512) >> 3) * 144 + (tid & 7) * 16) = pf5; \
        *(uint4*)((unsigned char*)ATs + (tid >> 3) * 144 + (tid & 7) * 16) = pf6; } while (0)
    SCAN_LOAD((c64_0) * 4 + h);
    SCAN_STORE();
    f32x4 av[4];
#define UF2AV(R, U) do { av[R][0] = __uint_as_float(U.x << 16); av[R][1] = __uint_as_float(U.x & 0xffff0000u); av[R][2] = __uint_as_float(U.y << 16); av[R][3] = __uint_as_float(U.y & 0xffff0000u); } while (0)
    UF2AV(0, uf0); UF2AV(1, uf1); UF2AV(2, uf2); UF2AV(3, uf3);
    float glc = gl;
    __syncthreads();
    const int r = tid >> 3, cgi = tid & 7;
    const float* ngp = a.in[I_GNG] + l * 128 + cgi * 16;
    for (int n = 0; n < nch; ++n) {
        const int tok0 = (c64_0 + n) * 64;
        if (n + 1 < nch) SCAN_LOAD((c64_0 + n + 1) * 4 + h);
        const uint4* zp = (const uint4*)(H + (size_t)(tok0 + r) * HW + 1536 + h * 128 + cgi * 16);
        const uint4 z0 = zp[0], z1 = zp[1];
#pragma unroll 1
        for (int ks = 0; ks < 4; ++ks) {
            const bf16x8 sf = *(const bf16x8*)(ST + (16 * wid + lr) * 136 + 32 * ks + 8 * lq);
#pragma unroll
            for (int rt = 0; rt < 4; ++rt) { const bf16x8 af = *(const bf16x8*)(NWs + (16 * rt + lr) * 136 + 32 * ks + 8 * lq); av[rt] = mfma16(af, sf, av[rt]); }
        }
#pragma unroll
        for (int rt = 0; rt < 4; ++rt) *(uint2*)(VNT + (16 * wid + lr) * 72 + 16 * rt + 4 * lq) = pack4(av[rt]);
        __syncthreads();
        f32x4 ao[4];
#pragma unroll
        for (int rt = 0; rt < 4; ++rt) ao[rt] = (f32x4){0.f, 0.f, 0.f, 0.f};
#pragma unroll 1
        for (int ks = 0; ks < 4; ++ks) {
            const bf16x8 sf = *(const bf16x8*)(ST + (16 * wid + lr) * 136 + 32 * ks + 8 * lq);
#pragma unroll
            for (int rt = 0; rt < 4; ++rt) { const bf16x8 af = *(const bf16x8*)(QDs + (16 * rt + lr) * 136 + 32 * ks + 8 * lq); ao[rt] = mfma16(af, sf, ao[rt]); }
        }
#pragma unroll
        for (int dt = 0; dt < 8; ++dt) aS[dt] *= glc;
#pragma unroll 1
        for (int ks = 0; ks < 2; ++ks) {
            const bf16x8 vf = *(const bf16x8*)(VNT + (16 * wid + lr) * 72 + 32 * ks + 8 * lq);
#pragma unroll
            for (int rt = 0; rt < 4; ++rt) { const bf16x8 af = *(const bf16x8*)(ATs + (16 * rt + lr) * 72 + 32 * ks + 8 * lq); ao[rt] = mfma16(af, vf, ao[rt]); }
#pragma unroll
            for (int dt = 0; dt < 8; ++dt) { const bf16x8 af = *(const bf16x8*)(KDTs + (16 * dt + lr) * 72 + 32 * ks + 8 * lq); aS[dt] = mfma16(af, vf, aS[dt]); }
        }
#pragma unroll
        for (int rt = 0; rt < 4; ++rt)
#pragma unroll
            for (int x = 0; x < 4; ++x) OB[(16 * rt + 4 * lq + x) * 132 + 16 * wid + lr] = ao[rt][x];
        __syncthreads();
#pragma unroll
        for (int dt = 0; dt < 8; ++dt) *(uint2*)(ST + (16 * wid + lr) * 136 + 16 * dt + 4 * lq) = pack4(aS[dt]);
        {
            float o[16], z[16];
#pragma unroll
            for (int i = 0; i < 4; ++i) { const float4 t = *(const float4*)(OB + r * 132 + cgi * 16 + 4 * i); o[4 * i] = t.x; o[4 * i + 1] = t.y; o[4 * i + 2] = t.z; o[4 * i + 3] = t.w; }
            float ss = 0.f;
#pragma unroll
            for (int i = 0; i < 16; ++i) ss += o[i] * o[i];
            ss += __shfl_xor(ss, 1); ss += __shfl_xor(ss, 2); ss += __shfl_xor(ss, 4);
            const float rs = rsqrtf(ss * (1.0f / 128.0f) + 1e-6f);
            unpack8(z0, z); unpack8(z1, z + 8);
#pragma unroll
            for (int i = 0; i < 16; ++i) o[i] = o[i] * rs * ngp[i] * (z[i] / (1.0f + expf(-z[i])));
            bf16_t* yp = Y + (size_t)(tok0 + r) * DM + h * 128 + cgi * 16;
            *(uint4*)yp = pack8(o); *(uint4*)(yp + 8) = pack8(o + 8);
        }
        if (n + 1 < nch) {
            SCAN_STORE();
            UF2AV(0, uf0); UF2AV(1, uf1); UF2AV(2, uf2); UF2AV(3, uf3);
            glc = gl;
        }
        __syncthreads();
    }
#undef SCAN_LOAD
#undef UF2AV
#undef SCAN_STORE
    float* so = a.out + (sample ? O_DELTAS + (size_t)((l * 8 + b) * 4 + h) * 16384 : O_DELTAP + (size_t)((l * 16 + b) * 4 + h) * 16384);
#pragma unroll
    for (int dt = 0; dt < 8; ++dt)
#pragma unroll
        for (int x = 0; x < 4; ++x) so[(16 * dt + 4 * lq + x) * 128 + 16 * wid + lr] = aS[dt][x];
    __syncthreads();
}

template <int NT>
__device__ __forceinline__ void smlp_item(const Args& a, unsigned char* lds, int l, int tok0, float* vout) {
    constexpr int NRT = NT / 16, NKS = NT / 32;
    const int tid = opaque_v(threadIdx.x), lane = tid & 63, wid = tid >> 6, lr = lane & 15, lq = lane >> 4;
    bf16_t* Vn = (bf16_t*)lds;
    const bf16_t* H = (const bf16_t*)(a.ws + WS_BIG); bf16_t* Y = (bf16_t*)(a.ws + WS_Y);
    {
        const float* lg = a.in[I_SLNG] + l * 512 + lane * 8; const float* lb = a.in[I_SLNB] + l * 512 + lane * 8;
        float g8[8], b8[8];
#pragma unroll
        for (int i = 0; i < 8; ++i) { g8[i] = lg[i]; b8[i] = lb[i]; }
        for (int q = wid; q < NT; q += 8) {
            const uint4 raw = *(const uint4*)(H + (size_t)(tok0 + q) * HW + 2560 + lane * 8);
            float x[8]; unpack8(raw, x);
            float s = 0.f;
#pragma unroll
            for (int i = 0; i < 8; ++i) { x[i] = gelu_f(x[i]); s += x[i]; }
            const float mean = wave_sum(s) * (1.0f / 512.0f);
            float qq = 0.f;
#pragma unroll
            for (int i = 0; i < 8; ++i) { x[i] -= mean; qq += x[i] * x[i]; }
            const float rstd = rsqrtf(wave_sum(qq) * (1.0f / 512.0f) + 1e-5f);
#pragma unroll
            for (int i = 0; i < 8; ++i) x[i] = x[i] * rstd * g8[i] + b8[i];
            *(uint4*)(Vn + q * 520 + lane * 8) = pack8(x);
            if (vout) { float* vp = vout + (size_t)q * 512 + lane * 8; *(float4*)vp = make_float4(x[0], x[1], x[2], x[3]); *(float4*)(vp + 4) = make_float4(x[4], x[5], x[6], x[7]); }
        }
    }
    __syncthreads();
    {
        const int g = wid >> 1, ch = wid & 1;
        bf16x8 bfr[NKS][4];
#pragma unroll
        for (int ks = 0; ks < NKS; ++ks)
#pragma unroll
            for (int ct = 0; ct < 4; ++ct)
#pragma unroll
                for (int jj = 0; jj < 8; ++jj) bfr[ks][ct][jj] = (short)Vn[(32 * ks + 8 * lq + jj) * 520 + g * 128 + 16 * (ch * 4 + ct) + lr];
        const float* Wg = a.in[I_WS] + (size_t)(l * 4 + g) * 16384; const float* bsg = a.in[I_BS] + (l * 4 + g) * 128;
#pragma unroll 1
        for (int rt = 0; rt < NRT; ++rt) {
            f32x4 c[4];
#pragma unroll
            for (int ct = 0; ct < 4; ++ct) c[ct] = (f32x4){0.f, 0.f, 0.f, 0.f};
#pragma unroll
            for (int ks = 0; ks < NKS; ++ks) {
                if (ks <= rt / 2) {
                    const int p = 16 * rt + lr, q0 = 32 * ks + 8 * lq;
                    const float4 w0 = *(const float4*)(Wg + p * 128 + q0), w1 = *(const float4*)(Wg + p * 128 + q0 + 4);
                    float w[8] = {w0.x, w0.y, w0.z, w0.w, w1.x, w1.y, w1.z, w1.w};
#pragma unroll
                    for (int jj = 0; jj < 8; ++jj) w[jj] = (q0 + jj <= p) ? w[jj] : 0.f;
                    const uint4 pk = pack8(w);
                    bf16x8 af; af[0] = (short)(pk.x & 0xffff); af[1] = (short)(pk.x >> 16); af[2] = (short)(pk.y & 0xffff); af[3] = (short)(pk.y >> 16);
                    af[4] = (short)(pk.z & 0xffff); af[5] = (short)(pk.z >> 16); af[6] = (short)(pk.w & 0xffff); af[7] = (short)(pk.w >> 16);
#pragma unroll
                    for (int ct = 0; ct < 4; ++ct) c[ct] = mfma16(af, bfr[ks][ct], c[ct]);
                }
            }
#pragma unroll
            for (int ct = 0; ct < 4; ++ct)
#pragma unroll
                for (int x = 0; x < 4; ++x) {
                    const int p = 16 * rt + 4 * lq + x, cc = g * 128 + 16 * (ch * 4 + ct) + lr;
                    const float s = c[ct][x] + bsg[p];
                    const float u = gelu_f(bf2f(H[(size_t)(tok0 + p) * HW + 2048 + cc]));
                    Y[(size_t)(tok0 + p) * DM + 512 + cc] = f2bf(u * s);
                }
        }
    }
    __syncthreads();
}

__device__ __forceinline__ void scan_phase(const Args& a, unsigned char* lds, int l) {
    const int bid = opaque_s(blockIdx.x); l = opaque_s(l);
#ifndef NO_SCAN
    if (bid < 96) scan_item(a, lds, l, bid);
#endif
#ifndef NO_SMLP
    if (bid >= 64) {
        for (int j = bid - 64; j < 520; j += gridDim.x - 64) {
            if (j < 512) smlp_item<128>(a, lds, l, j * 128, nullptr);
            else smlp_item<64>(a, lds, l, NPROMPT + (j - 512) * 64, a.out + O_SMLPV + (size_t)(l * 8 + (j - 512)) * 64 * 512);
        }
    }
#endif
}

__global__ void __launch_bounds__(512, 2) mega_fwd(Args a) {
    extern __shared__ __attribute__((aligned(16))) unsigned char lds[];
    cg::grid_group grid = cg::this_grid();
    bf16_t* XB = (bf16_t*)(a.ws + WS_XB);
    float* T1 = (float*)(a.ws + WS_BIG);
    bf16_t* Hb = (bf16_t*)(a.ws + WS_BIG);
    bf16_t* Yb = (bf16_t*)(a.ws + WS_Y);
#define RUN(n) ((n) >= a.ph_lo && (n) < a.ph_hi)
#define SYNC(n) do { if ((n) > a.ph_lo) grid.sync(); } while (0)
    if (RUN(0)) {
        weights_phase(a, lds);
        ln_phase(a, lds, a.in[I_XP], a.in[I_XS], a.in[I_LN0G], a.in[I_LN0B], false, nullptr, nullptr, true, 0);
    }
    for (int l = 0; l < 2; ++l) {
        const int p0 = 1 + 8 * l;
        for (int k = 0; k < 8; ++k) {
            const int ph = p0 + k;
            if (!RUN(ph)) continue;
            SYNC(ph);
            if (k == 0 || k == 5) {
                pg8::Gemm g; g.A = XB; g.M = NTOK; g.K = DM;
                EpiAct E;
                if (k == 0) { g.Bt = (const bf16_t*)(a.ws + WS_WIN) + (size_t)l * HW * DM; g.N = HW; E.O = Hb; E.ldc = HW; E.act = 0; }
                else { g.Bt = (const bf16_t*)(a.ws + WS_WUP) + (size_t)l * DFF * DM; g.N = DFF; E.O = Hb; E.ldc = DFF; E.act = 1; }
                pg8::StaticOrder S; S.init(g.M, g.N, gridDim.x, opaque_s(blockIdx.x));
#ifndef NO_GEMM
                pg8::gemm_phase<EpiAct, pg8::StaticOrder, false>((PG8_LAS unsigned char*)lds, g, S, E, nullptr);
#endif
            } else if (k == 3 || k == 6) {
                pg8::Gemm g; g.M = NTOK; g.N = DM;
                EpiRes E; E.X = XB;
                if (k == 3) { g.A = Yb; g.Bt = (const bf16_t*)(a.ws + WS_WOUT) + (size_t)l * DM * DM; g.K = DM; E.C = T1; }
                else { g.A = Hb; g.Bt = (const bf16_t*)(a.ws + WS_WDN) + (size_t)l * DM * DFF; g.K = DFF; E.C = a.out; }
                pg8::StaticOrder S; S.init(g.M, g.N, gridDim.x, opaque_s(blockIdx.x));
#ifndef NO_GEMM
                pg8::gemm_phase<EpiRes, pg8::StaticOrder, false>((PG8_LAS unsigned char*)lds, g, S, E, nullptr);
#endif
            } else if (k == 1) {
#ifndef NO_PREP
                prep_phase(a, lds, l);
#endif
            } else if (k == 2) {
#ifndef NO_SCANP
                scan_phase(a, lds, l);
#endif
            } else if (k == 4) {
                ln_phase(a, lds, T1, T1 + (size_t)NPROMPT * DM, a.in[I_LN1G] + l * DM, a.in[I_LN1B] + l * DM, false, nullptr, nullptr, false, 0);
            } else {
                ln_phase(a, lds, a.out, a.out + O_YS, a.in[I_LN2G] + l * DM, a.in[I_LN2B] + l * DM, l == 1, a.out, a.out + O_YS, l == 0, 1);
            }
        }
    }
#undef RUN
#undef SYNC
}

extern "C" void kernel_launch(void* const* d_in, const int* in_sizes, int n_in, void* d_out, int out_size, void* d_ws, size_t ws_size, hipStream_t stream) {
    static int grid = 0;
    if (grid == 0) {
        if (n_in != 22 || ws_size < WS_END) { fprintf(stderr, "kernel_launch: unexpected n_in %d / ws %zu\n", n_in, ws_size); grid = -1; return; }
        int dev = 0, cus = 0, per_cu = 0;
        (void)hipGetDevice(&dev);
        (void)hipDeviceGetAttribute(&cus, hipDeviceAttributeMultiprocessorCount, dev);
        if (hipFuncSetAttribute((const void*)mega_fwd, hipFuncAttributeMaxDynamicSharedMemorySize, LDS_BYTES) != hipSuccess) { fprintf(stderr, "kernel_launch: hipFuncSetAttribute failed\n"); grid = -1; return; }
        if (hipOccupancyMaxActiveBlocksPerMultiprocessor(&per_cu, (const void*)mega_fwd, 512, LDS_BYTES) != hipSuccess || per_cu < 1) { fprintf(stderr, "kernel_launch: occupancy query says %d\n", per_cu); per_cu = 1; }
        (void)hipGetLastError();
        grid = cus * per_cu;
        fprintf(stderr, "kernel_launch: grid %d (cus %d x %d)\n", grid, cus, per_cu);
    }
    if (grid < 0) return;
    Args a{};
    for (int i = 0; i < 22; ++i) a.in[i] = (const float*)d_in[i];
    a.out = (float*)d_out; a.ws = (unsigned char*)d_ws;
#if MK_MULTI
    for (int ph = 0; ph < NPHASE; ++ph) { a.ph_lo = ph; a.ph_hi = ph + 1; hipLaunchKernelGGL(mega_fwd, dim3(grid), dim3(512), LDS_BYTES, stream, a); }
#else
    a.ph_lo = 0; a.ph_hi = NPHASE;
    void* args[] = {&a};
    hipError_t e = hipLaunchCooperativeKernel((const void*)mega_fwd, dim3(grid), dim3(512), args, LDS_BYTES, stream);
    if (e != hipSuccess) fprintf(stderr, "kernel_launch: cooperative launch failed: %s (grid %d)\n", hipGetErrorString(e), grid);
#endif
}
```

```cpp
#include <hip/hip_runtime.h>
#include <hip/hip_cooperative_groups.h>
#include <cstdio>
#include <cstdint>
namespace cg = cooperative_groups;
#ifndef MK_MULTI
#define MK_MULTI 0
#endif
#ifndef REP_K
#define REP_K -1
#endif
#ifndef OLD_INV
#define OLD_INV 1
#endif
#ifndef BIS_GW
#define BIS_GW 0
#endif
#ifndef BIS_KDT
#define BIS_KDT 0
#endif
#ifndef BIS_S1
#define BIS_S1 1
#endif
#ifndef BIS_S2
#define BIS_S2 1
#endif
#ifndef BIS_RAW
#define BIS_RAW 1
#endif
#ifndef BIS_A
#define BIS_A 1
#endif
#ifndef BIS_B
#define BIS_B 1
#endif
namespace pg8 {
#define PG8_LAS __attribute__((address_space(3)))
typedef unsigned short bf16_t;
typedef short bf16x8 __attribute__((ext_vector_type(8)));
typedef float f32x4 __attribute__((ext_vector_type(4)));
typedef unsigned u32x4 __attribute__((ext_vector_type(4)));
constexpr int BM = 256, BK = 64, HALF = 128, HTB = HALF * BK * 2  , STAGE_BYTES = 8 * HTB, NXCD = 8, WGM = 8;

__host__ __device__ __forceinline__ int lds_byte(int r, int c) { const int st = (r >> 4) * 2 + (c >> 5), rr = r & 15, cc = c & 31, ob = rr * 64 + cc * 2; return st * 1024 + (ob ^ (((ob >> 9) & 1) << 5)); }
__host__ __device__ __forceinline__ void stage_rc(int b, int& R, int& C) { const int st = b / 1024, sb = b % 1024, swz = sb ^ (((sb >> 9) & 1) << 5); R = (st >> 1) * 16 + swz / 64; C = (st & 1) * 32 + (swz % 64) / 2; }
__host__ __device__ __forceinline__ int perm32(int rho) { const int n = rho >> 4, i = rho & 15; return 8 * (i >> 2) + 4 * n + (i & 3); }

struct Unit { int pm, pn; };
struct Gemm { const bf16_t* A; const bf16_t* Bt; int M, N, K; };

struct StaticOrder {
    int nM, nN, nwg, G, c;
    __host__ __device__ void init(int M, int N, int G_, int c_) { nM = M / BM; nN = N / BM; nwg = nM * nN; G = G_; c = c_; }
    __host__ __device__ bool next(int i, Unit& u) const {
        const long L = (long)i * G + c; if (L >= nwg) return false;
        int wgid = (int)L; { const int q = nwg / NXCD, r = nwg % NXCD, xcd = wgid % NXCD, off = wgid / NXCD; wgid = (xcd < r ? xcd * (q + 1) : r * (q + 1) + (xcd - r) * q) + off; }
        const int nig = WGM * nN, gid = wgid / nig, fm = gid * WGM, gsz = (nM - fm) < WGM ? (nM - fm) : WGM;
        u.pm = fm + ((wgid % nig) % gsz); u.pn = (wgid % nig) / gsz; return true;
    }
    __device__ __forceinline__ void a_ready(const Unit&) const {}
    __device__ __forceinline__ void done(const Unit&) const {}
};
typedef __bf16 bf16x2_cv __attribute__((ext_vector_type(2))); typedef float f32x2_cv __attribute__((ext_vector_type(2)));
__device__ __forceinline__ unsigned cvt_pk_bf16(float lo, float hi) { const f32x2_cv v = {lo, hi}; return __builtin_bit_cast(unsigned, __builtin_convertvector(v, bf16x2_cv)); }
template <class Epi, class Sched, bool STAMP = false>
__device__ __forceinline__ void gemm_phase(PG8_LAS unsigned char* lds, const Gemm g, const Sched& S, const Epi& E, unsigned long long* stamps) {
    int tid_ = threadIdx.x; asm volatile("" : "+v"(tid_)); const int tid = tid_, wid = __builtin_amdgcn_readfirstlane(tid >> 6), lane = tid & 63, wr = wid >> 2, wc = wid & 3, fr = lane & 15, fq = lane >> 4;
    const int K = g.K, nt = K / BK;
    int ts_lo = 0, ts_hi = 0, nts = 0; const unsigned long long rt_entry = STAMP ? (unsigned long long)wall_clock64() : 0ull;
#define PG8_STAMP() do { if (STAMP && wid == 0 && nts < 64) { const unsigned long long _c = (unsigned long long)clock64(); \
        ts_lo = (lane == nts) ? (int)(unsigned)_c : ts_lo; ts_hi = (lane == nts) ? (int)(unsigned)(_c >> 32) : ts_hi; ++nts; } } while (0)
    PG8_STAMP();
    unsigned voffA[2], voffB[2];
#pragma unroll
    for (int i = 0; i < 2; ++i) { int R, C; stage_rc(tid * 16 + i * 8192, R, C); const int Rb = Epi::PERM ? ((R & ~31) + perm32(R & 31)) : R;
        voffA[i] = (unsigned)(R * K + C) * 2u; voffB[i] = (unsigned)(Rb * K + C) * 2u; }
    const size_t kstep = (size_t)(BK * 2);
    const size_t hstep = (size_t)HALF * K * 2;
    const size_t tstep = 2 * hstep;
    const unsigned ldsw = (unsigned)wid * 1024u;
    const int aoff = lds_byte(wr * 64 + fr, fq * 8), boff = lds_byte(wc * 32 + fr, fq * 8);
#define PG8_SA(b, h) (((b) * 2 + (h)) * HTB)
#define PG8_SB(b, h) ((4 + (b) * 2 + (h)) * HTB)
#define PG8_STAGE(bufoff, gbase, voff) do { _Pragma("unroll") for (int _i = 0; _i < 2; ++_i) \
        __builtin_amdgcn_global_load_lds((const unsigned*)((const char*)(gbase) + (voff)[_i]), (PG8_LAS unsigned*)(lds + (bufoff) + ldsw + _i * 8192), 16, 0, 0); } while (0)
#define PG8_LDA(dst, b, h) do { _Pragma("unroll") for (int m = 0; m < 4; ++m) _Pragma("unroll") for (int k = 0; k < 2; ++k) dst[m][k] = *(const PG8_LAS bf16x8*)(lds + PG8_SA(b, h) + aoff + m * 2048 + k * 1024); } while (0)
#define PG8_LDB(dst, b, h) do { _Pragma("unroll") for (int n = 0; n < 2; ++n) _Pragma("unroll") for (int k = 0; k < 2; ++k) dst[n][k] = *(const PG8_LAS bf16x8*)(lds + PG8_SB(b, h) + boff + n * 2048 + k * 1024); } while (0)
#define PG8_MMA(ai, bj, At, Bt) do { __builtin_amdgcn_s_setprio(1); _Pragma("unroll") for (int m = 0; m < 4; ++m) _Pragma("unroll") for (int n = 0; n < 2; ++n) _Pragma("unroll") for (int k = 0; k < 2; ++k) \
        acc[ai][bj][m][n] = __builtin_amdgcn_mfma_f32_16x16x32_bf16(Bt[n][k], At[m][k], acc[ai][bj][m][n], 0, 0, 0); __builtin_amdgcn_s_setprio(0); } while (0)
#define PG8_WAIT_V(n) asm volatile("s_waitcnt vmcnt(" #n ")" ::: "memory")
#define PG8_WAIT_L(n) asm volatile("s_waitcnt lgkmcnt(" #n ")" ::: "memory")
#define PG8_BAR __builtin_amdgcn_s_barrier()
#define PG8_SCHED __builtin_amdgcn_sched_barrier(0)
    Unit cur, nxt; int ui = 0;
    if (!S.next(0, cur)) return;
    f32x4 acc[2][2][4][2];
#pragma unroll
    for (int a = 0; a < 2; ++a)
#pragma unroll
        for (int b = 0; b < 2; ++b)
#pragma unroll
            for (int m = 0; m < 4; ++m)
#pragma unroll
                for (int n = 0; n < 2; ++n) acc[a][b][m][n] = (f32x4){0.f, 0.f, 0.f, 0.f};
    bf16x8 At[4][2], B0[2][2], B1[2][2];
    const char* cA = (const char*)g.A + (size_t)cur.pm * tstep; const char* cB = (const char*)g.Bt + (size_t)cur.pn * tstep;
    S.a_ready(cur);
    PG8_STAGE(PG8_SB(0, 0), cB, voffB); PG8_STAGE(PG8_SA(0, 0), cA, voffA); PG8_STAGE(PG8_SB(0, 1), cB + hstep, voffB); PG8_STAGE(PG8_SA(0, 1), cA + hstep, voffA);
    if (wr == 1) PG8_BAR;
    PG8_WAIT_V(4); PG8_BAR;
    PG8_STAGE(PG8_SB(1, 0), cB + kstep, voffB); PG8_STAGE(PG8_SA(1, 0), cA + kstep, voffA); PG8_STAGE(PG8_SB(1, 1), cB + hstep + kstep, voffB);
    PG8_WAIT_V(6); PG8_BAR;
    PG8_STAMP();
    for (;;) {
        const bool has_next = S.next(ui + 1, nxt);
        const char* nA = has_next ? (const char*)g.A + (size_t)nxt.pm * tstep : cA; const char* nB = has_next ? (const char*)g.Bt + (size_t)nxt.pn * tstep : cB;
        for (int t = 0; t < nt; t += 2) {
            const bool last = (t == nt - 2);
            const char* a1 = cA + (size_t)(t + 1) * kstep;
            const char* a2 = last ? nA : cA + (size_t)(t + 2) * kstep; const char* b2 = last ? nB : cB + (size_t)(t + 2) * kstep;
            const char* a3 = a2 + kstep; const char* b3 = b2 + kstep;
            if (last && has_next) S.a_ready(nxt);
            PG8_LDB(B0, 0, 0); PG8_SCHED; PG8_LDA(At, 0, 0); PG8_STAGE(PG8_SA(1, 1), a1 + hstep, voffA);
            PG8_WAIT_L(8); PG8_BAR; PG8_WAIT_L(0); PG8_MMA(0, 0, At, B0); PG8_BAR; PG8_SCHED;
            PG8_LDB(B1, 0, 1); PG8_STAGE(PG8_SB(0, 0), b2, voffB);
            PG8_BAR; PG8_WAIT_L(0); PG8_MMA(0, 1, At, B1); PG8_BAR;
            PG8_LDA(At, 0, 1); PG8_STAGE(PG8_SA(0, 0), a2, voffA);
            PG8_BAR; PG8_WAIT_L(0); PG8_MMA(1, 0, At, B0); PG8_BAR; PG8_SCHED;
            PG8_STAGE(PG8_SB(0, 1), b2 + hstep, voffB);
            PG8_WAIT_V(6); PG8_BAR; PG8_MMA(1, 1, At, B1); PG8_BAR;
            PG8_LDB(B0, 1, 0); PG8_SCHED; PG8_LDA(At, 1, 0); PG8_STAGE(PG8_SA(0, 1), a2 + hstep, voffA);
            PG8_WAIT_L(8); PG8_BAR; PG8_WAIT_L(0); PG8_MMA(0, 0, At, B0); PG8_BAR; PG8_SCHED;
            PG8_LDB(B1, 1, 1); PG8_STAGE(PG8_SB(1, 0), b3, voffB);
            PG8_BAR; PG8_WAIT_L(0); PG8_MMA(0, 1, At, B1); PG8_BAR;
            PG8_LDA(At, 1, 1); PG8_STAGE(PG8_SA(1, 0), a3, voffA);
            PG8_BAR; PG8_WAIT_L(0); PG8_MMA(1, 0, At, B0); PG8_BAR; PG8_SCHED;
            PG8_STAGE(PG8_SB(1, 1), b3 + hstep, voffB);
            PG8_WAIT_V(6); PG8_BAR; PG8_MMA(1, 1, At, B1); PG8_BAR;
        }
        PG8_STAMP();
        if constexpr (!Epi::AFTER_DRAIN) { E(acc, cur, wr, wc, fr, fq); S.done(cur); }
        PG8_STAMP();
        if (!has_next) break;
#pragma unroll
        for (int a = 0; a < 2; ++a)
#pragma unroll
            for (int b = 0; b < 2; ++b)
#pragma unroll
                for (int m = 0; m < 4; ++m)
#pragma unroll
                    for (int n = 0; n < 2; ++n) acc[a][b][m][n] = (f32x4){0.f, 0.f, 0.f, 0.f};
        cur = nxt; cA = nA; cB = nB; ++ui;
    }
    PG8_WAIT_V(0);
    if (wr == 0) PG8_BAR;
    PG8_BAR;
    if constexpr (Epi::AFTER_DRAIN) { E.fused(acc, cur, wr, wc, fr, fq, lds, wid, lane); S.done(cur); }
    PG8_STAMP();
    if (STAMP && wid == 0) { stamps[lane] = lane < nts ? (((unsigned long long)(unsigned)ts_hi << 32) | (unsigned)ts_lo) : 0ull;
        if (lane == 62) stamps[62] = rt_entry; if (lane == 63) stamps[63] = (unsigned long long)wall_clock64(); }
#undef PG8_STAMP
#undef PG8_SA
#undef PG8_SB
#undef PG8_STAGE
#undef PG8_LDA
#undef PG8_LDB
#undef PG8_MMA
#undef PG8_WAIT_V
#undef PG8_WAIT_L
#undef PG8_BAR
#undef PG8_SCHED
}
}

using pg8::bf16_t; using pg8::bf16x8; using pg8::f32x4; using pg8::u32x4;

constexpr int DM = 1024, NTOK = 66048, NPROMPT = 65536, INW = 3080, HW = 3072, DFF = 4096;
constexpr int NITEM = 4128;
constexpr float DN_ALPHA = 1.4142135623730951f;
constexpr size_t WS_WIN = 0, WS_WOUT = 12582912, WS_WUP = 16777216, WS_WDN = 33554432, WS_XB = 50331648, WS_LOG = 185597952,
                 WS_ATT = 187711488, WS_GL = 221528064, WS_BIG = 221593600, WS_Y = WS_BIG + 405798912, WS_END = WS_BIG + 541065216, WS_CTL = WS_END, WS_T2 = WS_END + 65536, WS_END2 = WS_T2 + 135266304;
constexpr size_t O_YS = 67108864, O_CONVP = 67633152, O_DELTAP = 67780608, O_CONVS = 69877760, O_DELTAS = 69951488, O_SMLPV = 71000064;
constexpr int LDS_BYTES = 150016;
constexpr int NPHASE = 17;

struct Args { const float* in[22]; float* out; unsigned char* ws; int ph_lo, ph_hi; };
enum { I_XP = 0, I_XS, I_CCONV, I_SDELTA, I_LN0G, I_LN0B, I_WIN, I_CONVW, I_ALOG, I_DTB, I_GNG, I_SLNG, I_SLNB, I_WS, I_BS, I_WOUT, I_LN1G, I_LN1B, I_WUP, I_WDN, I_LN2G, I_LN2B };

__device__ __forceinline__ int opaque_v(int x) { asm volatile("" : "+v"(x)); return x; }
__device__ __forceinline__ int opaque_s(int x) { asm volatile("" : "+s"(x)); return x; }
__device__ __forceinline__ float bf2f(unsigned short b) { return __uint_as_float((unsigned)b << 16); }
__device__ __forceinline__ unsigned pk2(float lo, float hi) { return pg8::cvt_pk_bf16(lo, hi); }
__device__ __forceinline__ unsigned short f2bf(float f) { return (unsigned short)(pk2(f, 0.f) & 0xffffu); }
__device__ __forceinline__ void unpack8(const uint4 v, float* o) {
    o[0] = __uint_as_float(v.x << 16); o[1] = __uint_as_float(v.x & 0xffff0000u); o[2] = __uint_as_float(v.y << 16); o[3] = __uint_as_float(v.y & 0xffff0000u);
    o[4] = __uint_as_float(v.z << 16); o[5] = __uint_as_float(v.z & 0xffff0000u); o[6] = __uint_as_float(v.w << 16); o[7] = __uint_as_float(v.w & 0xffff0000u);
}
__device__ __forceinline__ uint4 pack8(const float* x) { uint4 r; r.x = pk2(x[0], x[1]); r.y = pk2(x[2], x[3]); r.z = pk2(x[4], x[5]); r.w = pk2(x[6], x[7]); return r; }
__device__ __forceinline__ uint2 pack4(const f32x4 v) { uint2 r; r.x = pk2(v[0], v[1]); r.y = pk2(v[2], v[3]); return r; }
template <int CTRL> __device__ __forceinline__ float dpp_mov(float v) { return __builtin_bit_cast(float, __builtin_amdgcn_update_dpp(0, __builtin_bit_cast(int, v), CTRL, 0xf, 0xf, true)); }
__device__ __forceinline__ float sum4(float v) { v += dpp_mov<0xB1>(v); v += dpp_mov<0x4E>(v); return v; }
__device__ __forceinline__ float sum8(float v) { v = sum4(v); v += dpp_mov<0x141>(v); return v; }
__device__ __forceinline__ float sum16(float v) { v = sum8(v); v += dpp_mov<0x140>(v); return v; }
__device__ __forceinline__ float wave_sum(float v) { v = sum16(v); v += __shfl_xor(v, 16); v += __shfl_xor(v, 32); return v; }
__device__ __forceinline__ float gelu_f(float v) {
    const float t = __builtin_amdgcn_rcpf(fabsf(v) * 0.2316418882f + 1.0f);
    float q = t * 0.5307027145f + (-0.7265760135f); q = q * t + 0.7107068705f; q = q * t + (-0.142248368f); q = q * t + 0.127414796f; q = q * t;
    const float e = __builtin_amdgcn_exp2f((v * v) * (-0.72134752044f));
    const float m = v * (q * e);
    return v < 0.f ? m : v - m;
}
__device__ __forceinline__ float silu_f(float x) { return x * __builtin_amdgcn_rcpf(1.0f + __builtin_amdgcn_exp2f(x * (-1.4426950408889634f))); }
__device__ __forceinline__ f32x4 mfma16(const bf16x8 a, const bf16x8 b, const f32x4 c) { return __builtin_amdgcn_mfma_f32_16x16x32_bf16(a, b, c, 0, 0, 0); }

struct EpiAct {
    static constexpr bool PERM = true, AFTER_DRAIN = false;
    bf16_t* O; int ldc; int act;
    __device__ __forceinline__ void operator()(const f32x4 (&acc)[2][2][4][2], const pg8::Unit& u, int wr, int wc, int fr, int fq) const {
        const int row0 = u.pm * 256 + wr * 64 + fr, col0 = u.pn * 256 + wc * 32 + 8 * fq;
#pragma unroll
        for (int ai = 0; ai < 2; ++ai)
#pragma unroll
            for (int m = 0; m < 4; ++m) { bf16_t* rowp = O + (size_t)(row0 + ai * 128 + m * 16) * ldc + col0;
#pragma unroll
                for (int bj = 0; bj < 2; ++bj) { f32x4 v0 = acc[ai][bj][m][0], v1 = acc[ai][bj][m][1];
                    if (act) {
#pragma unroll
                        for (int j = 0; j < 4; ++j) { float p = fmaxf(v0[j], 0.f), q = fmaxf(v1[j], 0.f); v0[j] = p * p; v1[j] = q * q; } }
                    u32x4 w; w.x = pk2(v0[0], v0[1]); w.y = pk2(v0[2], v0[3]); w.z = pk2(v1[0], v1[1]); w.w = pk2(v1[2], v1[3]);
                    *(u32x4*)(rowp + bj * 128) = w; } }
    }
};
struct EpiRes {
    static constexpr bool PERM = true, AFTER_DRAIN = false;
    bf16_t* O; const bf16_t* X;
    __device__ __forceinline__ void operator()(const f32x4 (&acc)[2][2][4][2], const pg8::Unit& u, int wr, int wc, int fr, int fq) const {
        const int row0 = u.pm * 256 + wr * 64 + fr, col0 = u.pn * 256 + wc * 32 + 8 * fq;
#pragma unroll
        for (int ai = 0; ai < 2; ++ai)
#pragma unroll
            for (int m = 0; m < 4; ++m) { const size_t ro = (size_t)(row0 + ai * 128 + m * 16) * DM + col0;
#pragma unroll
                for (int bj = 0; bj < 2; ++bj) { const size_t o = ro + bj * 128; const uint4 xv = *(const uint4*)(X + o);
                    u32x4 w;
                    w.x = pk2(acc[ai][bj][m][0][0] + DN_ALPHA * __uint_as_float(xv.x << 16), acc[ai][bj][m][0][1] + DN_ALPHA * __uint_as_float(xv.x & 0xffff0000u));
                    w.y = pk2(acc[ai][bj][m][0][2] + DN_ALPHA * __uint_as_float(xv.y << 16), acc[ai][bj][m][0][3] + DN_ALPHA * __uint_as_float(xv.y & 0xffff0000u));
                    w.z = pk2(acc[ai][bj][m][1][0] + DN_ALPHA * __uint_as_float(xv.z << 16), acc[ai][bj][m][1][1] + DN_ALPHA * __uint_as_float(xv.z & 0xffff0000u));
                    w.w = pk2(acc[ai][bj][m][1][2] + DN_ALPHA * __uint_as_float(xv.w << 16), acc[ai][bj][m][1][3] + DN_ALPHA * __uint_as_float(xv.w & 0xffff0000u));
                    *(u32x4*)(O + o) = w; __builtin_amdgcn_sched_barrier(0); } }
    }
};

__device__ __forceinline__ void transpose_tile(const float* __restrict__ src, int ld_src, bf16_t* __restrict__ dst, int ld_dst, int k0, int n0s, int n0d, float* tile) {
    const int tidt = opaque_v(threadIdx.x);
    {
        const int c4 = tidt & 15;
#pragma unroll
        for (int i = 0; i < 2; ++i) { const int k = (tidt >> 4) + 32 * i; const float4 v = *(const float4*)(src + (size_t)(k0 + k) * ld_src + n0s + c4 * 4);
            tile[k * 65 + c4 * 4] = v.x; tile[k * 65 + c4 * 4 + 1] = v.y; tile[k * 65 + c4 * 4 + 2] = v.z; tile[k * 65 + c4 * 4 + 3] = v.w; }
    }
    __syncthreads();
    {
        const int n = tidt >> 3, kseg = tidt & 7;
        float t8[8];
#pragma unroll
        for (int i = 0; i < 8; ++i) t8[i] = tile[(kseg * 8 + i) * 65 + n];
        *(uint4*)(dst + (size_t)(n0d + n) * ld_dst + k0 + kseg * 8) = pack8(t8);
    }
    __syncthreads();
}
__device__ __forceinline__ void weights_phase(const Args& a, unsigned char* lds, int l, int b0, int nb) {
    float* tile = (float*)lds;
    for (int t = b0; t < 3072; t += nb) {
        if (t < 768) { const int kt = t / 48, nt = t % 48; const int n0d = nt * 64, n0s = n0d < 2048 ? n0d : n0d + 8;
            transpose_tile(a.in[I_WIN] + (size_t)l * DM * INW, INW, (bf16_t*)(a.ws + WS_WIN) + (size_t)l * HW * DM, DM, kt * 64, n0s, n0d, tile); }
        else if (t < 1024) { const int q = t - 768, kt = q / 16, nt = q % 16;
            transpose_tile(a.in[I_WOUT] + (size_t)l * DM * DM, DM, (bf16_t*)(a.ws + WS_WOUT) + (size_t)l * DM * DM, DM, kt * 64, nt * 64, nt * 64, tile); }
        else if (t < 2048) { const int q = t - 1024, kt = q / 64, nt = q % 64;
            transpose_tile(a.in[I_WUP] + (size_t)l * DM * DFF, DFF, (bf16_t*)(a.ws + WS_WUP) + (size_t)l * DFF * DM, DM, kt * 64, nt * 64, nt * 64, tile); }
        else { const int q = t - 2048, kt = q / 16, nt = q % 16;
            transpose_tile(a.in[I_WDN] + (size_t)l * DFF * DM, DM, (bf16_t*)(a.ws + WS_WDN) + (size_t)l * DM * DFF, DFF, kt * 64, nt * 64, nt * 64, tile); }
    }
}

template <bool SRC_BF16>
__device__ __forceinline__ void ln_phase(const Args& a, unsigned char* lds, const void* srcP, const void* srcS, const float* __restrict__ g, const float* __restrict__ b,
                                         bool f32out, float* dstP, float* dstS, bool logits, int lnext, bool resid = false) {
    const int tid = opaque_v(threadIdx.x), lane = tid & 63, wid = tid >> 6;
    float* wl = (float*)lds;
    if (logits) {
        const float* w = a.in[I_WIN] + (size_t)lnext * DM * INW;
        for (int i = tid; i < 8192; i += 512) { const int k = i >> 3, j = i & 7; wl[j * 1024 + k] = w[(size_t)k * INW + 2048 + j]; }
        __syncthreads();
    }
    bf16_t* xb = (bf16_t*)(a.ws + WS_XB); float* LOG = (float*)(a.ws + WS_LOG);
    float gv[16], bv[16];
#pragma unroll
    for (int i = 0; i < 2; ++i)
#pragma unroll
        for (int e = 0; e < 2; ++e) { const float4 t = *(const float4*)(g + i * 512 + lane * 8 + 4 * e), u = *(const float4*)(b + i * 512 + lane * 8 + 4 * e);
            gv[i * 8 + e * 4] = t.x; gv[i * 8 + e * 4 + 1] = t.y; gv[i * 8 + e * 4 + 2] = t.z; gv[i * 8 + e * 4 + 3] = t.w;
            bv[i * 8 + e * 4] = u.x; bv[i * 8 + e * 4 + 1] = u.y; bv[i * 8 + e * 4 + 2] = u.z; bv[i * 8 + e * 4 + 3] = u.w; }
    uint4 pr0 = make_uint4(0u, 0u, 0u, 0u), pr1 = pr0, px0 = pr0, px1 = pr0;
#define LN_PREFETCH(ROW) do { const size_t ro_ = (ROW) < NPROMPT ? (size_t)(ROW) * DM : (size_t)((ROW) - NPROMPT) * DM; \
        const bf16_t* src_ = ((ROW) < NPROMPT ? (const bf16_t*)srcP : (const bf16_t*)srcS) + ro_; \
        pr0 = *(const uint4*)(src_ + lane * 8); pr1 = *(const uint4*)(src_ + 512 + lane * 8); \
        if (resid) { px0 = *(const uint4*)(xb + (size_t)(ROW) * DM + lane * 8); px1 = *(const uint4*)(xb + (size_t)(ROW) * DM + 512 + lane * 8); } } while (0)
    if (SRC_BF16) { const int row_first = opaque_s(blockIdx.x) * 8 + wid; if (row_first < NTOK) LN_PREFETCH(row_first); }
    for (int row = opaque_s(blockIdx.x) * 8 + wid; row < NTOK; row += gridDim.x * 8) {
        const size_t ro = row < NPROMPT ? (size_t)row * DM : (size_t)(row - NPROMPT) * DM;
        float v[16];
        if (SRC_BF16) {
            const uint4 r0 = pr0, r1 = pr1, x0 = px0, x1 = px1;
            { const int nrow = row + (int)gridDim.x * 8; if (nrow < NTOK) LN_PREFETCH(nrow); }
            unpack8(r0, v); unpack8(r1, v + 8);
            if (resid) {
                float xv[16]; unpack8(x0, xv); unpack8(x1, xv + 8);
#pragma unroll
                for (int i = 0; i < 16; ++i) v[i] += DN_ALPHA * xv[i];
            }
        } else {
            const float* src = (row < NPROMPT ? (const float*)srcP : (const float*)srcS) + ro;
#pragma unroll
            for (int i = 0; i < 2; ++i)
#pragma unroll
                for (int e = 0; e < 2; ++e) { const float4 t = *(const float4*)(src + i * 512 + lane * 8 + 4 * e); v[i * 8 + e * 4] = t.x; v[i * 8 + e * 4 + 1] = t.y; v[i * 8 + e * 4 + 2] = t.z; v[i * 8 + e * 4 + 3] = t.w; }
        }
        float s = 0.f;
#pragma unroll
        for (int i = 0; i < 16; ++i) s += v[i];
        const float mean = wave_sum(s) * (1.0f / 1024.0f);
        float q = 0.f;
#pragma unroll
        for (int i = 0; i < 16; ++i) { v[i] -= mean; q += v[i] * v[i]; }
        const float rstd = rsqrtf(wave_sum(q) * (1.0f / 1024.0f) + 1e-5f);
#pragma unroll
        for (int i = 0; i < 16; ++i) v[i] = v[i] * rstd * gv[i] + bv[i];
        if (!f32out) { *(uint4*)(xb + (size_t)row * DM + lane * 8) = pack8(v); *(uint4*)(xb + (size_t)row * DM + 512 + lane * 8) = pack8(v + 8); }
        if (f32out) { float* dst = (row < NPROMPT ? dstP : dstS) + ro;
#pragma unroll
            for (int i = 0; i < 2; ++i)
#pragma unroll
                for (int e = 0; e < 2; ++e) *(float4*)(dst + i * 512 + lane * 8 + 4 * e) = make_float4(v[i * 8 + e * 4], v[i * 8 + e * 4 + 1], v[i * 8 + e * 4 + 2], v[i * 8 + e * 4 + 3]); }
        if (logits) {
            float p[8];
#pragma unroll
            for (int j = 0; j < 8; ++j) { float q8 = 0.f;
#pragma unroll
                for (int i = 0; i < 2; ++i)
#pragma unroll
                    for (int e = 0; e < 2; ++e) { const float4 w = *(const float4*)(wl + j * 1024 + i * 512 + lane * 8 + 4 * e);
                        q8 += (v[i * 8 + e * 4] * w.x + v[i * 8 + e * 4 + 1] * w.y) + (v[i * 8 + e * 4 + 2] * w.z + v[i * 8 + e * 4 + 3] * w.w); }
                p[j] = q8; }
            const bool b0 = (lane & 1) != 0, b1 = (lane & 2) != 0, b2 = (lane & 4) != 0;
            float k1[4], k2[2], k3;
#pragma unroll
            for (int i = 0; i < 4; ++i) { const float send = b0 ? p[i] : p[4 + i], keep = b0 ? p[4 + i] : p[i]; k1[i] = keep + __shfl_xor(send, 1); }
#pragma unroll
            for (int i = 0; i < 2; ++i) { const float send = b1 ? k1[i] : k1[2 + i], keep = b1 ? k1[2 + i] : k1[i]; k2[i] = keep + __shfl_xor(send, 2); }
            { const float send = b2 ? k2[0] : k2[1], keep = b2 ? k2[1] : k2[0]; k3 = keep + __shfl_xor(send, 4); }
            k3 += __shfl_xor(k3, 8); k3 += __shfl_xor(k3, 16); k3 += __shfl_xor(k3, 32);
            if (lane < 8) LOG[(size_t)row * 8 + ((lane & 1) * 4 + ((lane >> 1) & 1) * 2 + ((lane >> 2) & 1))] = k3;
        }
    }
#undef LN_PREFETCH
    __syncthreads();
}

constexpr int PL_TM = 17408, PL_XM = 34816, PL_G = 39424, PL_CW = 40192, PL_KS = 64768, PL_QS = 82176, PL_VB = 99584, PL_KG = 116992;
#define PREP_PREFETCH(ITEM) do { const int t0_ = ((ITEM) >> 2) * 64, h_ = (ITEM) & 3; \
        _Pragma("unroll") for (int w_ = 0; w_ < 3; ++w_) _Pragma("unroll") for (int j_ = 0; j_ < 4; ++j_) { \
            int row_ = t0_ + r + j_ - 3; row_ = row_ < 0 ? 0 : row_; \
            const uint4* p_ = (const uint4*)(H + (size_t)row_ * HW + w_ * 512 + h_ * 128 + cgi * 16); raw[w_][j_][0] = p_[0]; raw[w_][j_][1] = p_[1]; } } while (0)
__device__ __forceinline__ void gdn_prep_item(const Args& a, unsigned char* lds, int l, int item, int nitem, uint4 (&raw)[3][4][2], float& pbl, float& pal) {
    const int tid = opaque_v(threadIdx.x), lane = tid & 63, wid = tid >> 6, lr = lane & 15, lq = lane >> 4;
    const int c64 = item >> 2, h = item & 3, tok0 = c64 * 64;
    const bool sample = c64 >= 1024;
    const int mode = sample ? 2 : ((c64 & 63) == 0 ? 0 : 1);
    const bf16_t* H = (const bf16_t*)(a.ws + WS_BIG);
    const float* LOG = (const float*)(a.ws + WS_LOG);
    float* Am = (float*)(lds); float* Tm = (float*)(lds + PL_TM); float* Xm = (float*)(lds + PL_XM);
    float* gcs = (float*)(lds + PL_G); float* bts = gcs + 64; float* egs = gcs + 128; const float* cws = (const float*)(lds + PL_CW);
    bf16_t* Ks = (bf16_t*)(lds + PL_KS); bf16_t* Qs = (bf16_t*)(lds + PL_QS); bf16_t* VBs = (bf16_t*)(lds + PL_VB); bf16_t* KGs = (bf16_t*)(lds + PL_KG);
    unsigned char* ib = (unsigned char*)a.out + (size_t)item * 65536;
    bf16_t* NW = (bf16_t*)ib; bf16_t* UF = (bf16_t*)(ib + 16384); bf16_t* QD = (bf16_t*)(ib + 32768); bf16_t* KDT = (bf16_t*)(ib + 49152);
    bf16_t* ATT = (bf16_t*)(a.ws + WS_ATT) + (size_t)item * 4096;
    const int r = tid >> 3, cgi = tid & 7;
    if (wid == 0) {
        const float bl = pbl, al = pal;
        { const int nt0 = (nitem >> 2) * 64, nh = nitem & 3; const float* lg = LOG + (size_t)(nt0 + lane) * 8; pbl = lg[nh]; pal = lg[4 + nh]; }
        const float A = expf(a.in[I_ALOG][l * 4 + h]); const float x = al + a.in[I_DTB][l * 4 + h];
        const float sp = x > 20.f ? x : log1pf(expf(x));
        float g = -A * sp;
#pragma unroll
        for (int o = 1; o < 64; o <<= 1) { const float t = __shfl_up(g, o); if (lane >= o) g += t; }
        const float gl = __shfl(g, 63);
        gcs[lane] = g; bts[lane] = 1.0f / (1.0f + expf(-bl)); egs[lane] = expf(gl - g);
        if (lane == 63) ((float*)(a.ws + WS_GL))[item] = expf(g);
    }
    for (int i = tid; i < 64 * 68; i += 512) Tm[i] = 0.f;
    __syncthreads();
    {
        const float gc = gcs[r], bt = bts[r];
        const float eg = expf(gc);
        const float* cc = a.in[I_CCONV] + (size_t)(l * 8 + (sample ? c64 - 1024 : 0)) * 3 * 1536;
#pragma unroll
        for (int which = 0; which < 3; ++which) {
            const int col = which * 512 + h * 128 + cgi * 16;
            float acc[16];
#pragma unroll
            for (int i = 0; i < 16; ++i) acc[i] = 0.f;
#pragma unroll
            for (int j = 0; j < 4; ++j) {
                const int rr = r + j - 3;
                float x[16];
                unpack8(raw[which][j][0], x); unpack8(raw[which][j][1], x + 8);
                if (rr < 0 && mode != 1) {
                    if (mode == 2) { const float4* p = (const float4*)(cc + (size_t)(rr + 3) * 1536 + col);
#pragma unroll
                        for (int i = 0; i < 4; ++i) { const float4 t = p[i]; x[4 * i] = t.x; x[4 * i + 1] = t.y; x[4 * i + 2] = t.z; x[4 * i + 3] = t.w; } }
                    else {
#pragma unroll
                        for (int i = 0; i < 16; ++i) x[i] = 0.f; }
                }
                const float4* wp = (const float4*)(cws + j * 1536 + col);
#pragma unroll
                for (int i = 0; i < 4; ++i) { const float4 w = wp[i]; acc[4 * i] += x[4 * i] * w.x; acc[4 * i + 1] += x[4 * i + 1] * w.y; acc[4 * i + 2] += x[4 * i + 2] * w.z; acc[4 * i + 3] += x[4 * i + 3] * w.w; }
            }
#pragma unroll
            for (int i = 0; i < 16; ++i) acc[i] = silu_f(acc[i]);
            if (which < 2) {
                float ss = 0.f;
#pragma unroll
                for (int i = 0; i < 16; ++i) ss += acc[i] * acc[i];
                ss = sum8(ss);
                const float sc = rsqrtf(ss + 1e-6f) * (which == 0 ? 0.08838834764831845f : 1.0f);
#pragma unroll
                for (int i = 0; i < 16; ++i) acc[i] *= sc;
            }
            float t[16];
            if (which == 0) {
                *(uint4*)(Qs + r * 136 + cgi * 16) = pack8(acc); *(uint4*)(Qs + r * 136 + cgi * 16 + 8) = pack8(acc + 8);
#pragma unroll
                for (int i = 0; i < 16; ++i) t[i] = acc[i] * eg;
                *(uint4*)(QD + r * 128 + cgi * 16) = pack8(t); *(uint4*)(QD + r * 128 + cgi * 16 + 8) = pack8(t + 8);
            } else if (which == 1) {
                *(uint4*)(Ks + r * 136 + cgi * 16) = pack8(acc); *(uint4*)(Ks + r * 136 + cgi * 16 + 8) = pack8(acc + 8);
                const float f = bt * eg;
#pragma unroll
                for (int i = 0; i < 16; ++i) t[i] = acc[i] * f;
                *(uint4*)(KGs + r * 136 + cgi * 16) = pack8(t); *(uint4*)(KGs + r * 136 + cgi * 16 + 8) = pack8(t + 8);
            } else {
#pragma unroll
                for (int i = 0; i < 16; ++i) t[i] = acc[i] * bt;
                *(uint4*)(VBs + r * 136 + cgi * 16) = pack8(t); *(uint4*)(VBs + r * 136 + cgi * 16 + 8) = pack8(t + 8);
            }
        }
        PREP_PREFETCH(nitem);
    }
    __syncthreads();
    {
        const int d = tid >> 2, seg = tid & 3;
        float t[16];
#pragma unroll
        for (int i = 0; i < 16; ++i) t[i] = bf2f(Ks[(seg * 16 + i) * 136 + d]) * egs[seg * 16 + i];
        *(uint4*)(KDT + d * 64 + seg * 16) = pack8(t); *(uint4*)(KDT + d * 64 + seg * 16 + 8) = pack8(t + 8);
    }
#pragma unroll
    for (int jt = 0; jt < 4; ++jt) {
        const int which = wid >> 2, it = wid & 3;
        f32x4 c = {0.f, 0.f, 0.f, 0.f};
        if (jt <= it) {
            const bf16_t* Bs = which ? Qs : Ks;
#pragma unroll
            for (int ks = 0; ks < 4; ++ks) {
                const bf16x8 af = *(const bf16x8*)(Ks + (16 * jt + lr) * 136 + 32 * ks + 8 * lq);
                const bf16x8 bf = *(const bf16x8*)(Bs + (16 * it + lr) * 136 + 32 * ks + 8 * lq);
                c = mfma16(af, bf, c);
            }
        }
        const int i = 16 * it + lr, j0 = 16 * jt + 4 * lq;
        const float gi = gcs[i];
        const float4 gj = *(const float4*)(gcs + j0);
        const float gjv[4] = {gj.x, gj.y, gj.z, gj.w};
        float v[4];
        if (which == 0) {
            const float bi = bts[i];
#pragma unroll
            for (int x = 0; x < 4; ++x) v[x] = (i > j0 + x) ? bi * c[x] * __expf(gi - gjv[x]) : 0.f;
            *(float4*)(Am + i * 68 + j0) = make_float4(v[0], v[1], v[2], v[3]);
        } else {
#pragma unroll
            for (int x = 0; x < 4; ++x) v[x] = (i >= j0 + x) ? c[x] * __expf(gi - gjv[x]) : 0.f;
            uint2 p; p.x = pk2(v[0], v[1]); p.y = pk2(v[2], v[3]);
            *(uint2*)(ATT + i * 64 + j0) = p;
        }
    }
    __syncthreads();
    if (wid == 0) {
        const int b = lane >> 4, c = lane & 15;
        float t[16];
#pragma unroll
        for (int i = 0; i < 16; ++i) t[i] = 0.f;
#pragma unroll
        for (int i = 0; i < 16; ++i) {
            float s = (i == c) ? 1.0f : 0.0f;
#pragma unroll
            for (int jq = 0; jq < (i + 3) / 4; ++jq) {
                const float4 a4 = *(const float4*)(Am + (16 * b + i) * 68 + 16 * b + 4 * jq);
                s -= a4.x * t[4 * jq]; s -= a4.y * t[4 * jq + 1]; s -= a4.z * t[4 * jq + 2]; s -= a4.w * t[4 * jq + 3];
            }
            t[i] = s;
            Tm[(16 * b + i) * 68 + 16 * b + c] = s;
        }
    }
    __syncthreads();
    {
        const int p = tid >> 8, i = (tid >> 4) & 15, j = tid & 15, r0 = 16 + 32 * p, c0 = 32 * p;
        float s = 0.f;
#pragma unroll
        for (int kq = 0; kq < 4; ++kq) { const float4 a4 = *(const float4*)(Am + (r0 + i) * 68 + c0 + 4 * kq);
            s += a4.x * Tm[(c0 + 4 * kq) * 68 + c0 + j]; s += a4.y * Tm[(c0 + 4 * kq + 1) * 68 + c0 + j]; s += a4.z * Tm[(c0 + 4 * kq + 2) * 68 + c0 + j]; s += a4.w * Tm[(c0 + 4 * kq + 3) * 68 + c0 + j]; }
        Xm[(p * 16 + i) * 36 + j] = s;
        __syncthreads();
        float u = 0.f;
#pragma unroll
        for (int kq = 0; kq < 4; ++kq) { const float4 t4 = *(const float4*)(Tm + (r0 + i) * 68 + r0 + 4 * kq);
            u += t4.x * Xm[(p * 16 + 4 * kq) * 36 + j]; u += t4.y * Xm[(p * 16 + 4 * kq + 1) * 36 + j]; u += t4.z * Xm[(p * 16 + 4 * kq + 2) * 36 + j]; u += t4.w * Xm[(p * 16 + 4 * kq + 3) * 36 + j]; }
        Tm[(r0 + i) * 68 + c0 + j] = -u;
    }
    __syncthreads();
    {
        const int i = tid >> 4, j0 = (tid & 15) * 2;
        float s0 = 0.f, s1 = 0.f;
#pragma unroll
        for (int kq = 0; kq < 8; ++kq) { const float4 a4 = *(const float4*)(Am + (32 + i) * 68 + 4 * kq);
            const float av[4] = {a4.x, a4.y, a4.z, a4.w};
#pragma unroll
            for (int e = 0; e < 4; ++e) { const float2 tv = *(const float2*)(Tm + (4 * kq + e) * 68 + j0); s0 += av[e] * tv.x; s1 += av[e] * tv.y; } }
        *(float2*)(Xm + i * 36 + j0) = make_float2(s0, s1);
        __syncthreads();
        float u0 = 0.f, u1 = 0.f;
#pragma unroll
        for (int kq = 0; kq < 8; ++kq) { const float4 t4 = *(const float4*)(Tm + (32 + i) * 68 + 32 + 4 * kq);
            const float tv4[4] = {t4.x, t4.y, t4.z, t4.w};
#pragma unroll
            for (int e = 0; e < 4; ++e) { const float2 xv = *(const float2*)(Xm + (4 * kq + e) * 36 + j0); u0 += tv4[e] * xv.x; u1 += tv4[e] * xv.y; } }
        *(float2*)(Tm + (32 + i) * 68 + j0) = make_float2(-u0, -u1);
    }
    __syncthreads();
    {
        bf16x8 tf[4][2];
#pragma unroll
        for (int rt = 0; rt < 4; ++rt)
#pragma unroll
            for (int ks = 0; ks < 2; ++ks) {
                const float4 t0 = *(const float4*)(Tm + (16 * rt + lr) * 68 + 32 * ks + 8 * lq), t1 = *(const float4*)(Tm + (16 * rt + lr) * 68 + 32 * ks + 8 * lq + 4);
                const unsigned p0 = pk2(t0.x, t0.y), p1 = pk2(t0.z, t0.w), p2 = pk2(t1.x, t1.y), p3 = pk2(t1.z, t1.w);
                bf16x8 f; f[0] = (short)(p0 & 0xffff); f[1] = (short)(p0 >> 16); f[2] = (short)(p1 & 0xffff); f[3] = (short)(p1 >> 16);
                f[4] = (short)(p2 & 0xffff); f[5] = (short)(p2 >> 16); f[6] = (short)(p3 & 0xffff); f[7] = (short)(p3 >> 16);
                tf[rt][ks] = f;
            }
#pragma unroll
        for (int mat = 0; mat < 2; ++mat) {
            const bf16_t* X = mat ? KGs : VBs;
            f32x4 c[4];
#pragma unroll
            for (int rt = 0; rt < 4; ++rt) c[rt] = (f32x4){0.f, 0.f, 0.f, 0.f};
#pragma unroll
            for (int ks = 0; ks < 2; ++ks) {
                bf16x8 xf;
#pragma unroll
                for (int jj = 0; jj < 8; ++jj) xf[jj] = (short)X[(32 * ks + 8 * lq + jj) * 136 + 16 * wid + lr];
#pragma unroll
                for (int rt = 0; rt < 4; ++rt) c[rt] = mat ? mfma16(xf, tf[rt][ks], c[rt]) : mfma16(tf[rt][ks], xf, c[rt]);
            }
            if (mat == 0) {
#pragma unroll
                for (int rt = 0; rt < 4; ++rt) *(uint2*)(UF + ((rt * 8 + wid) * 64 + lane) * 4) = pack4(c[rt]);
            } else {
#pragma unroll
                for (int rt = 0; rt < 4; ++rt) { const f32x4 n = -c[rt]; *(uint2*)(NW + (16 * rt + lr) * 128 + 16 * wid + 4 * lq) = pack4(n); }
            }
        }
    }
    __syncthreads();
}

__device__ __forceinline__ void prep_phase(const Args& a, unsigned char* lds, int l) {
    l = opaque_s(l);
    {
        const int tid = opaque_v(threadIdx.x);
        const float4* src = (const float4*)(a.in[I_CONVW] + (size_t)l * 4 * 1536); float4* dst = (float4*)(lds + PL_CW);
        for (int i = tid; i < 1536; i += 512) dst[i] = src[i];
        __syncthreads();
    }
    {
        const int tid = opaque_v(threadIdx.x), lane = tid & 63, r = tid >> 3, cgi = tid & 7;
        const bf16_t* H = (const bf16_t*)(a.ws + WS_BIG);
        uint4 raw[3][4][2]; float pbl = 0.f, pal = 0.f;
        int item = opaque_s(blockIdx.x);
        if (item < NITEM) {
            PREP_PREFETCH(item);
            if (tid < 64) { const float* lg = (const float*)(a.ws + WS_LOG) + (size_t)((item >> 2) * 64 + lane) * 8; pbl = lg[item & 3]; pal = lg[4 + (item & 3)]; }
        }
        for (; item < NITEM; item += gridDim.x) { const int nx = item + (int)gridDim.x; gdn_prep_item(a, lds, l, item, nx < NITEM ? nx : item, raw, pbl, pal); }
    }
    const bf16_t* H = (const bf16_t*)(a.ws + WS_BIG);
    for (int i = opaque_s(blockIdx.x) * 512 + opaque_v(threadIdx.x); i < 24 * 3 * 1536; i += gridDim.x * 512) {
        const int col = i % 1536, j = (i / 1536) % 3, s = i / 4608;
        if (s < 16) a.out[O_CONVP + ((size_t)(l * 16 + s) * 3 + j) * 1536 + col] = bf2f(H[(size_t)(s * 4096 + 4093 + j) * HW + col]);
        else a.out[O_CONVS + ((size_t)(l * 8 + (s - 16)) * 3 + j) * 1536 + col] = bf2f(H[(size_t)(NPROMPT + (s - 16) * 64 + 61 + j) * HW + col]);
    }
    __syncthreads();
}

__device__ __forceinline__ void scan_item(const Args& a, unsigned char* lds, int l, int sidx) {
    const int tid = opaque_v(threadIdx.x), lane = tid & 63, wid = tid >> 6, lr = lane & 15, lq = lane >> 4;
    const int wr = wid >> 2, wc = wid & 3;
    const bool sample = sidx >= 64;
    const int b = sample ? (sidx - 64) >> 2 : sidx >> 2, h = sidx & 3, nch = sample ? 1 : 64, c64_0 = sample ? 1024 + b : b * 64;
    bf16_t* ST = (bf16_t*)lds; bf16_t* VNT = (bf16_t*)(lds + 34816); bf16_t* NWs = (bf16_t*)(lds + 53248); bf16_t* QDs = (bf16_t*)(lds + 70656);
    bf16_t* KDTs = (bf16_t*)(lds + 88064); bf16_t* ATs = (bf16_t*)(lds + 106496); float* OB = (float*)(lds + 115712);
    const bf16_t* H = (const bf16_t*)(a.ws + WS_BIG); bf16_t* Y = (bf16_t*)(a.ws + WS_Y);
    const float* GL = (const float*)(a.ws + WS_GL);
    f32x4 aS[4][2];
    if (sample) {
        const float* s0 = a.in[I_SDELTA] + (size_t)((l * 8 + b) * 4 + h) * 16384;
#pragma unroll
        for (int dt = 0; dt < 4; ++dt)
#pragma unroll
            for (int et = 0; et < 2; ++et) {
#pragma unroll
                for (int x = 0; x < 4; ++x) aS[dt][et][x] = s0[(16 * (4 * wr + dt) + 4 * lq + x) * 128 + 16 * (2 * wc + et) + lr];
                *(uint2*)(ST + (16 * (2 * wc + et) + lr) * 136 + 16 * (4 * wr + dt) + 4 * lq) = pack4(aS[dt][et]);
            }
    } else {
#pragma unroll
        for (int dt = 0; dt < 4; ++dt)
#pragma unroll
            for (int et = 0; et < 2; ++et) { aS[dt][et] = (f32x4){0.f, 0.f, 0.f, 0.f}; *(uint2*)(ST + (16 * (2 * wc + et) + lr) * 136 + 16 * (4 * wr + dt) + 4 * lq) = make_uint2(0u, 0u); }
    }
    uint4 pf0, pf1, pf2, pf3, pf4, pf5, pf6; uint2 uf0, uf1, uf2, uf3; float gl;
#define SCAN_LOAD(ITEM) do { const unsigned char* ib_ = (const unsigned char*)a.out + (size_t)(ITEM) * 65536; \
        pf0 = *(const uint4*)(ib_ + (size_t)tid * 16); pf1 = *(const uint4*)(ib_ + (size_t)(tid + 512) * 16); \
        pf2 = *(const uint4*)(ib_ + 32768 + (size_t)tid * 16); pf3 = *(const uint4*)(ib_ + 32768 + (size_t)(tid + 512) * 16); \
        pf4 = *(const uint4*)(ib_ + 49152 + (size_t)tid * 16); pf5 = *(const uint4*)(ib_ + 49152 + (size_t)(tid + 512) * 16); \
        pf6 = *(const uint4*)((const unsigned char*)(a.ws + WS_ATT) + (size_t)(ITEM) * 8192 + (size_t)tid * 16); \
        uf0 = *(const uint2*)(ib_ + 16384 + (size_t)(((2 * wr + 0) * 8 + 2 * wc + 0) * 64 + lane) * 8); \
        uf1 = *(const uint2*)(ib_ + 16384 + (size_t)(((2 * wr + 0) * 8 + 2 * wc + 1) * 64 + lane) * 8); \
        uf2 = *(const uint2*)(ib_ + 16384 + (size_t)(((2 * wr + 1) * 8 + 2 * wc + 0) * 64 + lane) * 8); \
        uf3 = *(const uint2*)(ib_ + 16384 + (size_t)(((2 * wr + 1) * 8 + 2 * wc + 1) * 64 + lane) * 8); \
        gl = GL[ITEM]; } while (0)
#define SCAN_STORE() do { \
        *(uint4*)((unsigned char*)NWs + (tid >> 4) * 272 + (tid & 15) * 16) = pf0; *(uint4*)((unsigned char*)NWs + ((tid + 512) >> 4) * 272 + (tid & 15) * 16) = pf1; \
        *(uint4*)((unsigned char*)QDs + (tid >> 4) * 272 + (tid & 15) * 16) = pf2; *(uint4*)((unsigned char*)QDs + ((tid + 512) >> 4) * 272 + (tid & 15) * 16) = pf3; \
        *(uint4*)((unsigned char*)KDTs + (tid >> 3) * 144 + (tid & 7) * 16) = pf4; *(uint4*)((unsigned char*)KDTs + ((tid + 512) >> 3) * 144 + (tid & 7) * 16) = pf5; \
        *(uint4*)((unsigned char*)ATs + (tid >> 3) * 144 + (tid & 7) * 16) = pf6; } while (0)
    SCAN_LOAD((c64_0) * 4 + h);
    SCAN_STORE();
    f32x4 av[2][2];
#define UF2AV(CT, ET, U) do { av[CT][ET][0] = __uint_as_float(U.x << 16); av[CT][ET][1] = __uint_as_float(U.x & 0xffff0000u); av[CT][ET][2] = __uint_as_float(U.y << 16); av[CT][ET][3] = __uint_as_float(U.y & 0xffff0000u); } while (0)
    UF2AV(0, 0, uf0); UF2AV(0, 1, uf1); UF2AV(1, 0, uf2); UF2AV(1, 1, uf3);
    float glc = gl;
    __syncthreads();
    const int r = tid >> 3, cgi = tid & 7;
    float* NGs = (float*)(lds + 149504);
    if (tid < 128) NGs[tid] = a.in[I_GNG][l * 128 + tid];
    __syncthreads();
    for (int n = 0; n < nch; ++n) {
        const int tok0 = (c64_0 + n) * 64;
        { const int nn = (n + 1 < nch) ? n + 1 : n; SCAN_LOAD((c64_0 + nn) * 4 + h); }
        bf16x8 sfr[4][2], qf[4][2];
        {
            bf16x8 nwf[4][2];
#pragma unroll
            for (int ks = 0; ks < 4; ++ks) {
#pragma unroll
                for (int et = 0; et < 2; ++et) sfr[ks][et] = *(const bf16x8*)(ST + (16 * (2 * wc + et) + lr) * 136 + 32 * ks + 8 * lq);
#pragma unroll
                for (int ct = 0; ct < 2; ++ct) nwf[ks][ct] = *(const bf16x8*)(NWs + (16 * (2 * wr + ct) + lr) * 136 + 32 * ks + 8 * lq);
            }
#pragma unroll
            for (int ks = 0; ks < 4; ++ks)
#pragma unroll
                for (int ct = 0; ct < 2; ++ct) qf[ks][ct] = *(const bf16x8*)(QDs + (16 * (2 * wr + ct) + lr) * 136 + 32 * ks + 8 * lq);
            __builtin_amdgcn_sched_barrier(0);
#pragma unroll
            for (int ks = 0; ks < 4; ++ks)
#pragma unroll
                for (int ct = 0; ct < 2; ++ct)
#pragma unroll
                    for (int et = 0; et < 2; ++et) av[ct][et] = mfma16(nwf[ks][ct], sfr[ks][et], av[ct][et]);
        }
#pragma unroll
        for (int ct = 0; ct < 2; ++ct)
#pragma unroll
            for (int et = 0; et < 2; ++et) *(uint2*)(VNT + (16 * (2 * wc + et) + lr) * 72 + 16 * (2 * wr + ct) + 4 * lq) = pack4(av[ct][et]);
        __syncthreads();
        const uint4* zp = (const uint4*)(H + (size_t)(tok0 + r) * HW + 1536 + h * 128 + cgi * 16);
        const uint4 z0 = zp[0], z1 = zp[1];
        f32x4 ao[2][2];
#pragma unroll
        for (int ct = 0; ct < 2; ++ct)
#pragma unroll
            for (int et = 0; et < 2; ++et) ao[ct][et] = (f32x4){0.f, 0.f, 0.f, 0.f};
        {
            bf16x8 vf0[2], at0[2], kf0[4], vf1[2], at1[2], kf1[4];
#pragma unroll
            for (int et = 0; et < 2; ++et) vf0[et] = *(const bf16x8*)(VNT + (16 * (2 * wc + et) + lr) * 72 + 8 * lq);
#pragma unroll
            for (int ct = 0; ct < 2; ++ct) at0[ct] = *(const bf16x8*)(ATs + (16 * (2 * wr + ct) + lr) * 72 + 8 * lq);
#pragma unroll
            for (int dt = 0; dt < 4; ++dt) kf0[dt] = *(const bf16x8*)(KDTs + (16 * (4 * wr + dt) + lr) * 72 + 8 * lq);
            __builtin_amdgcn_sched_barrier(0);
#pragma unroll
            for (int ks = 0; ks < 4; ++ks)
#pragma unroll
                for (int ct = 0; ct < 2; ++ct)
#pragma unroll
                    for (int et = 0; et < 2; ++et) ao[ct][et] = mfma16(sfr[ks][et], qf[ks][ct], ao[ct][et]);
#pragma unroll
            for (int dt = 0; dt < 4; ++dt)
#pragma unroll
                for (int et = 0; et < 2; ++et) aS[dt][et] *= glc;
#pragma unroll
            for (int et = 0; et < 2; ++et) vf1[et] = *(const bf16x8*)(VNT + (16 * (2 * wc + et) + lr) * 72 + 32 + 8 * lq);
#pragma unroll
            for (int ct = 0; ct < 2; ++ct) at1[ct] = *(const bf16x8*)(ATs + (16 * (2 * wr + ct) + lr) * 72 + 32 + 8 * lq);
#pragma unroll
            for (int dt = 0; dt < 4; ++dt) kf1[dt] = *(const bf16x8*)(KDTs + (16 * (4 * wr + dt) + lr) * 72 + 32 + 8 * lq);
            __builtin_amdgcn_sched_barrier(0);
#pragma unroll
            for (int ct = 0; ct < 2; ++ct)
#pragma unroll
                for (int et = 0; et < 2; ++et) ao[ct][et] = mfma16(vf0[et], at0[ct], ao[ct][et]);
#pragma unroll
            for (int dt = 0; dt < 4; ++dt)
#pragma unroll
                for (int et = 0; et < 2; ++et) aS[dt][et] = mfma16(kf0[dt], vf0[et], aS[dt][et]);
#pragma unroll
            for (int ct = 0; ct < 2; ++ct)
#pragma unroll
                for (int et = 0; et < 2; ++et) ao[ct][et] = mfma16(vf1[et], at1[ct], ao[ct][et]);
#pragma unroll
            for (int dt = 0; dt < 4; ++dt)
#pragma unroll
                for (int et = 0; et < 2; ++et) aS[dt][et] = mfma16(kf1[dt], vf1[et], aS[dt][et]);
            __builtin_amdgcn_sched_barrier(0);
        }
#pragma unroll
        for (int ct = 0; ct < 2; ++ct)
#pragma unroll
            for (int et = 0; et < 2; ++et) *(float4*)(OB + (16 * (2 * wr + ct) + lr) * 132 + 16 * (2 * wc + et) + 4 * lq) = make_float4(ao[ct][et][0], ao[ct][et][1], ao[ct][et][2], ao[ct][et][3]);
        __syncthreads();
        SCAN_STORE();
        UF2AV(0, 0, uf0); UF2AV(0, 1, uf1); UF2AV(1, 0, uf2); UF2AV(1, 1, uf3);
        asm volatile("" : "+v"(gl));
        glc = gl;
#pragma unroll
        for (int dt = 0; dt < 4; ++dt)
#pragma unroll
            for (int et = 0; et < 2; ++et) *(uint2*)(ST + (16 * (2 * wc + et) + lr) * 136 + 16 * (4 * wr + dt) + 4 * lq) = pack4(aS[dt][et]);
        {
            float o[16], z[16];
#pragma unroll
            for (int i = 0; i < 4; ++i) { const float4 t = *(const float4*)(OB + r * 132 + cgi * 16 + 4 * i); o[4 * i] = t.x; o[4 * i + 1] = t.y; o[4 * i + 2] = t.z; o[4 * i + 3] = t.w; }
            float ss = 0.f;
#pragma unroll
            for (int i = 0; i < 16; ++i) ss += o[i] * o[i];
            ss = sum8(ss);
            const float rs = rsqrtf(ss * (1.0f / 128.0f) + 1e-6f);
            unpack8(z0, z); unpack8(z1, z + 8);
            float ng[16];
#pragma unroll
            for (int i = 0; i < 4; ++i) { const float4 t = *(const float4*)(NGs + cgi * 16 + 4 * i); ng[4 * i] = t.x; ng[4 * i + 1] = t.y; ng[4 * i + 2] = t.z; ng[4 * i + 3] = t.w; }
#pragma unroll
            for (int i = 0; i < 16; ++i) o[i] = o[i] * rs * ng[i] * silu_f(z[i]);
            bf16_t* yp = Y + (size_t)(tok0 + r) * DM + h * 128 + cgi * 16;
            *(uint4*)yp = pack8(o); *(uint4*)(yp + 8) = pack8(o + 8);
        }
        __syncthreads();
    }
#undef SCAN_LOAD
#undef UF2AV
#undef SCAN_STORE
    float* so = a.out + (sample ? O_DELTAS + (size_t)((l * 8 + b) * 4 + h) * 16384 : O_DELTAP + (size_t)((l * 16 + b) * 4 + h) * 16384);
#pragma unroll
    for (int dt = 0; dt < 4; ++dt)
#pragma unroll
        for (int et = 0; et < 2; ++et)
#pragma unroll
            for (int x = 0; x < 4; ++x) so[(16 * (4 * wr + dt) + 4 * lq + x) * 128 + 16 * (2 * wc + et) + lr] = aS[dt][et][x];
    __syncthreads();
}

template <int NT>
__device__ __forceinline__ void smlp_item(const Args& a, unsigned char* lds, int l, int tok0, float* vout) {
    constexpr int NRT = NT / 16, NKS = NT / 32;
    const int tid = opaque_v(threadIdx.x), lane = tid & 63, wid = tid >> 6, lr = lane & 15, lq = lane >> 4;
    bf16_t* Vn = (bf16_t*)lds;
    const bf16_t* H = (const bf16_t*)(a.ws + WS_BIG); bf16_t* Y = (bf16_t*)(a.ws + WS_Y);
    {
        const float* lg = a.in[I_SLNG] + l * 512 + lane * 8; const float* lb = a.in[I_SLNB] + l * 512 + lane * 8;
        float g8[8], b8[8];
#pragma unroll
        for (int i = 0; i < 8; ++i) { g8[i] = lg[i]; b8[i] = lb[i]; }
        for (int q0 = wid; q0 < NT; q0 += 32) {
            uint4 raw[4];
#pragma unroll
            for (int u = 0; u < 4; ++u) raw[u] = *(const uint4*)(H + (size_t)(tok0 + q0 + 8 * u) * HW + 2560 + lane * 8);
            float x[4][8], sm[4], qq[4];
#pragma unroll
            for (int u = 0; u < 4; ++u) { unpack8(raw[u], x[u]); sm[u] = 0.f;
#pragma unroll
                for (int i = 0; i < 8; ++i) { x[u][i] = gelu_f(x[u][i]); sm[u] += x[u][i]; } }
#pragma unroll
            for (int u = 0; u < 4; ++u) sm[u] = wave_sum(sm[u]);
#pragma unroll
            for (int u = 0; u < 4; ++u) { const float mean = sm[u] * (1.0f / 512.0f); qq[u] = 0.f;
#pragma unroll
                for (int i = 0; i < 8; ++i) { x[u][i] -= mean; qq[u] += x[u][i] * x[u][i]; } }
#pragma unroll
            for (int u = 0; u < 4; ++u) qq[u] = wave_sum(qq[u]);
#pragma unroll
            for (int u = 0; u < 4; ++u) { const int q = q0 + 8 * u; const float rstd = rsqrtf(qq[u] * (1.0f / 512.0f) + 1e-5f);
#pragma unroll
                for (int i = 0; i < 8; ++i) x[u][i] = x[u][i] * rstd * g8[i] + b8[i];
                *(uint4*)(Vn + q * 520 + lane * 8) = pack8(x[u]);
                if (vout) { float* vp = vout + (size_t)q * 512 + lane * 8; *(float4*)vp = make_float4(x[u][0], x[u][1], x[u][2], x[u][3]); *(float4*)(vp + 4) = make_float4(x[u][4], x[u][5], x[u][6], x[u][7]); } }
        }
    }
    __syncthreads();
    {
        const int g = wid >> 1, ch = wid & 1;
        bf16x8 bfr[NKS][4];
#pragma unroll
        for (int ks = 0; ks < NKS; ++ks)
#pragma unroll
            for (int ct = 0; ct < 4; ++ct)
#pragma unroll
                for (int jj = 0; jj < 8; ++jj) bfr[ks][ct][jj] = (short)Vn[(32 * ks + 8 * lq + jj) * 520 + g * 128 + 16 * (ch * 4 + ct) + lr];
        const float* Wg = a.in[I_WS] + (size_t)(l * 4 + g) * 16384; const float* bsg = a.in[I_BS] + (l * 4 + g) * 128;
        float4 wc[NKS][2], wn[NKS][2]; uint2 uc[4], un[4];
#define SMLP_FETCH(RT, W, U) do { const int p_ = 16 * (RT) + lr; \
            _Pragma("unroll") for (int ks_ = 0; ks_ < NKS; ++ks_) if (ks_ <= (RT) / 2) { (W)[ks_][0] = *(const float4*)(Wg + p_ * 128 + 32 * ks_ + 8 * lq); (W)[ks_][1] = *(const float4*)(Wg + p_ * 128 + 32 * ks_ + 8 * lq + 4); } \
            _Pragma("unroll") for (int ct_ = 0; ct_ < 4; ++ct_) (U)[ct_] = *(const uint2*)(H + (size_t)(tok0 + p_) * HW + 2048 + g * 128 + 16 * (ch * 4 + ct_) + 4 * lq); } while (0)
#pragma unroll
        for (int ks = 0; ks < NKS; ++ks) { wc[ks][0] = wc[ks][1] = wn[ks][0] = wn[ks][1] = make_float4(0.f, 0.f, 0.f, 0.f); }
        SMLP_FETCH(0, wc, uc);
#pragma unroll 1
        for (int rt = 0; rt < NRT; ++rt) {
            if (rt + 1 < NRT) SMLP_FETCH(rt + 1, wn, un);
            f32x4 c[4];
#pragma unroll
            for (int ct = 0; ct < 4; ++ct) c[ct] = (f32x4){0.f, 0.f, 0.f, 0.f};
#pragma unroll
            for (int ks = 0; ks < NKS; ++ks) {
                if (ks <= rt / 2) {
                    const int p = 16 * rt + lr, q0 = 32 * ks + 8 * lq;
                    const float4 w0 = wc[ks][0], w1 = wc[ks][1];
                    float w[8] = {w0.x, w0.y, w0.z, w0.w, w1.x, w1.y, w1.z, w1.w};
#pragma unroll
                    for (int jj = 0; jj < 8; ++jj) w[jj] = (q0 + jj <= p) ? w[jj] : 0.f;
                    const uint4 pk = pack8(w);
                    bf16x8 af; af[0] = (short)(pk.x & 0xffff); af[1] = (short)(pk.x >> 16); af[2] = (short)(pk.y & 0xffff); af[3] = (short)(pk.y >> 16);
                    af[4] = (short)(pk.z & 0xffff); af[5] = (short)(pk.z >> 16); af[6] = (short)(pk.w & 0xffff); af[7] = (short)(pk.w >> 16);
#pragma unroll
                    for (int ct = 0; ct < 4; ++ct) c[ct] = mfma16(bfr[ks][ct], af, c[ct]);
                }
            }
            {
                const int p = 16 * rt + lr; const float bsp = bsg[p];
#pragma unroll
                for (int ct = 0; ct < 4; ++ct) {
                    const float u0 = gelu_f(__uint_as_float(uc[ct].x << 16)), u1 = gelu_f(__uint_as_float(uc[ct].x & 0xffff0000u)), u2 = gelu_f(__uint_as_float(uc[ct].y << 16)), u3 = gelu_f(__uint_as_float(uc[ct].y & 0xffff0000u));
                    uint2 yv; yv.x = pk2(u0 * (c[ct][0] + bsp), u1 * (c[ct][1] + bsp)); yv.y = pk2(u2 * (c[ct][2] + bsp), u3 * (c[ct][3] + bsp));
                    *(uint2*)(Y + (size_t)(tok0 + p) * DM + 512 + g * 128 + 16 * (ch * 4 + ct) + 4 * lq) = yv;
                }
            }
#pragma unroll
            for (int ks = 0; ks < NKS; ++ks) { wc[ks][0] = wn[ks][0]; wc[ks][1] = wn[ks][1]; }
#pragma unroll
            for (int ct = 0; ct < 4; ++ct) uc[ct] = un[ct];
        }
#undef SMLP_FETCH
    }
    __syncthreads();
}

__device__ __forceinline__ void scan_phase(const Args& a, unsigned char* lds, int l) {
    const int bid = opaque_s(blockIdx.x); l = opaque_s(l);
#ifndef NO_SCAN
    if (bid < 96) scan_item(a, lds, l, bid);
#endif
#ifndef NO_SMLP
    if (bid >= 64) {
        for (int rep = 0; rep < (REP_K == 3 ? 2 : 1); ++rep)
        for (int j = bid - 64; j < 520; j += gridDim.x - 64) {
            if (j < 512) smlp_item<128>(a, lds, l, j * 128, nullptr);
            else smlp_item<64>(a, lds, l, NPROMPT + (j - 512) * 64, a.out + O_SMLPV + (size_t)(l * 8 + (j - 512)) * 64 * 512);
        }
        if (l == 0) weights_phase(a, lds, 1, bid - 64, gridDim.x - 64);
    }
#endif
}

__device__ __forceinline__ void small_gemm_phase(unsigned char* lds, const bf16_t* __restrict__ A, const bf16_t* __restrict__ Bt, int N, int K, bf16_t* O, int ldc, int mode, const bf16_t* X) {
    const int tid = opaque_v(threadIdx.x), lane = tid & 63, wid = tid >> 6, lr = lane & 15, lq = lane >> 4;
    const int ntiles = 16 * (N >> 6), Ks = K >> 3, nks = Ks >> 5;
    float* P = (float*)lds;
    for (int t = opaque_s(blockIdx.x); t < ntiles; t += gridDim.x) {
        const int mt = t & 15, nt = t >> 4, row0 = NPROMPT + mt * 32, col0 = nt * 64;
        f32x4 acc[2][4];
#pragma unroll
        for (int i = 0; i < 2; ++i)
#pragma unroll
            for (int j = 0; j < 4; ++j) acc[i][j] = (f32x4){0.f, 0.f, 0.f, 0.f};
        const bf16_t* ap = A + (size_t)(row0 + lr) * K + wid * Ks + 8 * lq;
        const bf16_t* bp = Bt + (size_t)(col0 + lr) * K + wid * Ks + 8 * lq;
#pragma unroll 4
        for (int ks = 0; ks < nks; ++ks) {
            bf16x8 af[2], bf[4];
#pragma unroll
            for (int i = 0; i < 2; ++i) af[i] = *(const bf16x8*)(ap + (size_t)i * 16 * K + ks * 32);
#pragma unroll
            for (int j = 0; j < 4; ++j) bf[j] = *(const bf16x8*)(bp + (size_t)j * 16 * K + ks * 32);
#pragma unroll
            for (int i = 0; i < 2; ++i)
#pragma unroll
                for (int j = 0; j < 4; ++j) acc[i][j] = mfma16(af[i], bf[j], acc[i][j]);
        }
        float* Pw = P + wid * (32 * 68);
#pragma unroll
        for (int i = 0; i < 2; ++i)
#pragma unroll
            for (int j = 0; j < 4; ++j)
#pragma unroll
                for (int x = 0; x < 4; ++x) Pw[(16 * i + 4 * lq + x) * 68 + 16 * j + lr] = acc[i][j][x];
        __syncthreads();
        {
            const int row = tid >> 4, c4 = (tid & 15) * 4;
            float4 v = *(const float4*)(P + row * 68 + c4);
#pragma unroll
            for (int w = 1; w < 8; ++w) { const float4 u = *(const float4*)(P + w * (32 * 68) + row * 68 + c4); v.x += u.x; v.y += u.y; v.z += u.z; v.w += u.w; }
            const size_t o = (size_t)(row0 + row) * ldc + col0 + c4;
            if (mode == 1) { v.x = fmaxf(v.x, 0.f); v.y = fmaxf(v.y, 0.f); v.z = fmaxf(v.z, 0.f); v.w = fmaxf(v.w, 0.f); v.x *= v.x; v.y *= v.y; v.z *= v.z; v.w *= v.w; }
            if (mode == 2) { const uint2 xv = *(const uint2*)(X + o);
                v.x += DN_ALPHA * __uint_as_float(xv.x << 16); v.y += DN_ALPHA * __uint_as_float(xv.x & 0xffff0000u); v.z += DN_ALPHA * __uint_as_float(xv.y << 16); v.w += DN_ALPHA * __uint_as_float(xv.y & 0xffff0000u); }
            uint2 p; p.x = pk2(v.x, v.y); p.y = pk2(v.z, v.w);
            *(uint2*)(O + o) = p;
        }
        __syncthreads();
    }
}

__device__ __forceinline__ void grid_bar(unsigned* ctl, unsigned round) {
    asm volatile("s_waitcnt vmcnt(0) lgkmcnt(0)" ::: "memory");
    __syncthreads();
    if (threadIdx.x == 0) {
        __builtin_amdgcn_fence(__ATOMIC_RELEASE, "agent");
        asm volatile("s_waitcnt vmcnt(0) lgkmcnt(0)" ::: "memory");
        const unsigned g = blockIdx.x & 7u, per = (gridDim.x - g + 7u) >> 3, ngrp = gridDim.x < 8u ? gridDim.x : 8u;
        const unsigned old = __hip_atomic_fetch_add(ctl + 64u * (1u + g), 1u, __ATOMIC_RELAXED, __HIP_MEMORY_SCOPE_AGENT);
        if (old + 1u == round * per) __hip_atomic_fetch_add(ctl, 1u, __ATOMIC_RELAXED, __HIP_MEMORY_SCOPE_AGENT);
        while (__hip_atomic_load(ctl, __ATOMIC_RELAXED, __HIP_MEMORY_SCOPE_AGENT) < round * ngrp) __builtin_amdgcn_s_sleep(1);
        __builtin_amdgcn_fence(__ATOMIC_ACQUIRE, "agent");
        asm volatile("s_waitcnt vmcnt(0) lgkmcnt(0)" ::: "memory");
    }
    __syncthreads();
}

__global__ void __launch_bounds__(512, 2) mega_fwd(Args a) {
    extern __shared__ __attribute__((aligned(16))) unsigned char lds[];
    cg::grid_group grid = cg::this_grid();
    unsigned nbar = 0;
    bf16_t* XB = (bf16_t*)(a.ws + WS_XB);
    bf16_t* T1 = (bf16_t*)(a.ws + WS_BIG);
    bf16_t* T2 = (bf16_t*)(a.ws + WS_T2);
    bf16_t* Hb = (bf16_t*)(a.ws + WS_BIG);
    bf16_t* Yb = (bf16_t*)(a.ws + WS_Y);
#define RUN(n) ((n) >= a.ph_lo && (n) < a.ph_hi)
#define SYNC(n) do { if ((n) > a.ph_lo) { if (a.ph_hi > 1000) grid.sync(); ++nbar; grid_bar((unsigned*)(a.ws + WS_CTL), nbar); } } while (0)
    if (RUN(0)) {
        weights_phase(a, lds, 0, opaque_s(blockIdx.x), gridDim.x);
        ln_phase<false>(a, lds, a.in[I_XP], a.in[I_XS], a.in[I_LN0G], a.in[I_LN0B], false, nullptr, nullptr, true, 0);
    }
    for (int l = 0; l < 2; ++l) {
        const int p0 = 1 + 8 * l;
        for (int k = 0; k < 8; ++k) {
            const int ph = p0 + k;
            if (!RUN(ph)) continue;
            SYNC(ph);
            for (int rep2 = 0; rep2 < ((REP_K >= 10 && k == REP_K - 10) ? 2 : 1); ++rep2) {
            if (k == 0 || k == 3 || k == 5 || k == 6) {
                pg8::Gemm g; g.M = NPROMPT; EpiAct E; E.act = 0;
                if (k == 0) { g.A = XB; g.Bt = (const bf16_t*)(a.ws + WS_WIN) + (size_t)l * HW * DM; g.N = HW; g.K = DM; E.O = Hb; E.ldc = HW; }
                else if (k == 3) { g.A = Yb; g.Bt = (const bf16_t*)(a.ws + WS_WOUT) + (size_t)l * DM * DM; g.N = DM; g.K = DM; E.O = T1; E.ldc = DM; }
                else if (k == 5) { g.A = XB; g.Bt = (const bf16_t*)(a.ws + WS_WUP) + (size_t)l * DFF * DM; g.N = DFF; g.K = DM; E.O = Hb; E.ldc = DFF; E.act = 1; }
                else { g.A = Hb; g.Bt = (const bf16_t*)(a.ws + WS_WDN) + (size_t)l * DM * DFF; g.N = DM; g.K = DFF; E.O = T2; E.ldc = DM; }
                pg8::StaticOrder S; S.init(g.M, g.N, gridDim.x, opaque_s(blockIdx.x));
#ifndef NO_GEMM
                pg8::gemm_phase<EpiAct, pg8::StaticOrder, false>((PG8_LAS unsigned char*)lds, g, S, E, nullptr);
#endif
                small_gemm_phase(lds, g.A, g.Bt, g.N, g.K, E.O, E.ldc, E.act, nullptr);
            } else if (k == 1) {
#ifndef NO_PREP
                for (int rep = 0; rep < (REP_K == 1 ? 2 : 1); ++rep) prep_phase(a, lds, l);
#endif
            } else if (k == 2) {
#ifndef NO_SCANP
                for (int rep = 0; rep < (REP_K == 2 ? 2 : 1); ++rep) scan_phase(a, lds, l);
#endif
            } else if (k == 4) {
                ln_phase<true>(a, lds, T1, T1 + (size_t)NPROMPT * DM, a.in[I_LN1G] + l * DM, a.in[I_LN1B] + l * DM, false, nullptr, nullptr, false, 0, true);
            } else {
                ln_phase<true>(a, lds, T2, T2 + (size_t)NPROMPT * DM, a.in[I_LN2G] + l * DM, a.in[I_LN2B] + l * DM, opaque_s(l) == 1, a.out, a.out + O_YS, opaque_s(l) == 0, 1, true);
            }
            }
        }
    }
#undef RUN
#undef SYNC
}

extern "C" void kernel_launch(void* const* d_in, const int* in_sizes, int n_in, void* d_out, int out_size, void* d_ws, size_t ws_size, hipStream_t stream) {
    static int grid = 0;
    if (grid == 0) {
        if (n_in != 22 || ws_size < WS_END2) { fprintf(stderr, "kernel_launch: unexpected n_in %d / ws %zu\n", n_in, ws_size); grid = -1; return; }
        int dev = 0, cus = 0, per_cu = 0;
        (void)hipGetDevice(&dev);
        (void)hipDeviceGetAttribute(&cus, hipDeviceAttributeMultiprocessorCount, dev);
        if (hipFuncSetAttribute((const void*)mega_fwd, hipFuncAttributeMaxDynamicSharedMemorySize, LDS_BYTES) != hipSuccess) { fprintf(stderr, "kernel_launch: hipFuncSetAttribute failed\n"); grid = -1; return; }
        if (hipOccupancyMaxActiveBlocksPerMultiprocessor(&per_cu, (const void*)mega_fwd, 512, LDS_BYTES) != hipSuccess || per_cu < 1) { fprintf(stderr, "kernel_launch: occupancy query says %d\n", per_cu); per_cu = 1; }
        (void)hipGetLastError();
        grid = cus * per_cu;
        fprintf(stderr, "kernel_launch: grid %d (cus %d x %d)\n", grid, cus, per_cu);
    }
    if (grid < 0) return;
    (void)hipMemsetAsync((unsigned char*)d_ws + WS_CTL, 0, 4096, stream);
    Args a{};
    for (int i = 0; i < 22; ++i) a.in[i] = (const float*)d_in[i];
    a.out = (float*)d_out; a.ws = (unsigned char*)d_ws;
#if MK_MULTI
    for (int ph = 0; ph < NPHASE; ++ph) { a.ph_lo = ph; a.ph_hi = ph + 1; hipLaunchKernelGGL(mega_fwd, dim3(grid), dim3(512), LDS_BYTES, stream, a); }
#else
    a.ph_lo = 0; a.ph_hi = NPHASE;
    void* args[] = {&a};
    hipError_t e = hipLaunchCooperativeKernel((const void*)mega_fwd, dim3(grid), dim3(512), args, LDS_BYTES, stream);
    if (e != hipSuccess) fprintf(stderr, "kernel_launch: cooperative launch failed: %s (grid %d)\n", hipGetErrorString(e), grid);
#endif
}
```

```cpp
#include <hip/hip_runtime.h>
#include <hip/hip_cooperative_groups.h>
#include <cstdio>
#include <cstdint>
namespace cg = cooperative_groups;
#ifndef MK_MULTI
#define MK_MULTI 0
#endif
#ifndef REP_K
#define REP_K -1
#endif
#ifndef OLD_INV
#define OLD_INV 1
#endif
#ifndef BIS_GW
#define BIS_GW 0
#endif
#ifndef BIS_KDT
#define BIS_KDT 0
#endif
#ifndef BIS_S1
#define BIS_S1 1
#endif
#ifndef BIS_S2
#define BIS_S2 1
#endif
#ifndef BIS_RAW
#define BIS_RAW 1
#endif
#ifndef BIS_A
#define BIS_A 1
#endif
#ifndef BIS_B
#define BIS_B 1
#endif
namespace pg8 {
#define PG8_LAS __attribute__((address_space(3)))
typedef unsigned short bf16_t;
typedef short bf16x8 __attribute__((ext_vector_type(8)));
typedef float f32x4 __attribute__((ext_vector_type(4)));
typedef unsigned u32x4 __attribute__((ext_vector_type(4)));
constexpr int BM = 256, BK = 64, HALF = 128, HTB = HALF * BK * 2  , STAGE_BYTES = 8 * HTB, NXCD = 8, WGM = 8;

__host__ __device__ __forceinline__ int lds_byte(int r, int c) { const int st = (r >> 4) * 2 + (c >> 5), rr = r & 15, cc = c & 31, ob = rr * 64 + cc * 2; return st * 1024 + (ob ^ (((ob >> 9) & 1) << 5)); }
__host__ __device__ __forceinline__ void stage_rc(int b, int& R, int& C) { const int st = b / 1024, sb = b % 1024, swz = sb ^ (((sb >> 9) & 1) << 5); R = (st >> 1) * 16 + swz / 64; C = (st & 1) * 32 + (swz % 64) / 2; }
__host__ __device__ __forceinline__ int perm32(int rho) { const int n = rho >> 4, i = rho & 15; return 8 * (i >> 2) + 4 * n + (i & 3); }

struct Unit { int pm, pn; };
struct Gemm { const bf16_t* A; const bf16_t* Bt; int M, N, K; };

struct StaticOrder {
    int nM, nN, nwg, G, c;
    __host__ __device__ void init(int M, int N, int G_, int c_) { nM = M / BM; nN = N / BM; nwg = nM * nN; G = G_; c = c_; }
    __host__ __device__ bool next(int i, Unit& u) const {
        const long L = (long)i * G + c; if (L >= nwg) return false;
        int wgid = (int)L; { const int q = nwg / NXCD, r = nwg % NXCD, xcd = wgid % NXCD, off = wgid / NXCD; wgid = (xcd < r ? xcd * (q + 1) : r * (q + 1) + (xcd - r) * q) + off; }
        const int nig = WGM * nN, gid = wgid / nig, fm = gid * WGM, gsz = (nM - fm) < WGM ? (nM - fm) : WGM;
        u.pm = fm + ((wgid % nig) % gsz); u.pn = (wgid % nig) / gsz; return true;
    }
    __device__ __forceinline__ void a_ready(const Unit&) const {}
    __device__ __forceinline__ void done(const Unit&) const {}
};
typedef __bf16 bf16x2_cv __attribute__((ext_vector_type(2))); typedef float f32x2_cv __attribute__((ext_vector_type(2)));
__device__ __forceinline__ unsigned cvt_pk_bf16(float lo, float hi) { const f32x2_cv v = {lo, hi}; return __builtin_bit_cast(unsigned, __builtin_convertvector(v, bf16x2_cv)); }
template <class Epi, class Sched, bool STAMP = false>
__device__ __forceinline__ void gemm_phase(PG8_LAS unsigned char* lds, const Gemm g, const Sched& S, const Epi& E, unsigned long long* stamps) {
    int tid_ = threadIdx.x; asm volatile("" : "+v"(tid_)); const int tid = tid_, wid = __builtin_amdgcn_readfirstlane(tid >> 6), lane = tid & 63, wr = wid >> 2, wc = wid & 3, fr = lane & 15, fq = lane >> 4;
    const int K = g.K, nt = K / BK;
    int ts_lo = 0, ts_hi = 0, nts = 0; const unsigned long long rt_entry = STAMP ? (unsigned long long)wall_clock64() : 0ull;
#define PG8_STAMP() do { if (STAMP && wid == 0 && nts < 64) { const unsigned long long _c = (unsigned long long)clock64(); \
        ts_lo = (lane == nts) ? (int)(unsigned)_c : ts_lo; ts_hi = (lane == nts) ? (int)(unsigned)(_c >> 32) : ts_hi; ++nts; } } while (0)
    PG8_STAMP();
    unsigned voffA[2], voffB[2];
#pragma unroll
    for (int i = 0; i < 2; ++i) { int R, C; stage_rc(tid * 16 + i * 8192, R, C); const int Rb = Epi::PERM ? ((R & ~31) + perm32(R & 31)) : R;
        voffA[i] = (unsigned)(R * K + C) * 2u; voffB[i] = (unsigned)(Rb * K + C) * 2u; }
    const size_t kstep = (size_t)(BK * 2);
    const size_t hstep = (size_t)HALF * K * 2;
    const size_t tstep = 2 * hstep;
    const unsigned ldsw = (unsigned)wid * 1024u;
    const int aoff = lds_byte(wr * 64 + fr, fq * 8), boff = lds_byte(wc * 32 + fr, fq * 8);
#define PG8_SA(b, h) (((b) * 2 + (h)) * HTB)
#define PG8_SB(b, h) ((4 + (b) * 2 + (h)) * HTB)
#define PG8_STAGE(bufoff, gbase, voff) do { _Pragma("unroll") for (int _i = 0; _i < 2; ++_i) \
        __builtin_amdgcn_global_load_lds((const unsigned*)((const char*)(gbase) + (voff)[_i]), (PG8_LAS unsigned*)(lds + (bufoff) + ldsw + _i * 8192), 16, 0, 0); } while (0)
#define PG8_LDA(dst, b, h) do { _Pragma("unroll") for (int m = 0; m < 4; ++m) _Pragma("unroll") for (int k = 0; k < 2; ++k) dst[m][k] = *(const PG8_LAS bf16x8*)(lds + PG8_SA(b, h) + aoff + m * 2048 + k * 1024); } while (0)
#define PG8_LDB(dst, b, h) do { _Pragma("unroll") for (int n = 0; n < 2; ++n) _Pragma("unroll") for (int k = 0; k < 2; ++k) dst[n][k] = *(const PG8_LAS bf16x8*)(lds + PG8_SB(b, h) + boff + n * 2048 + k * 1024); } while (0)
#define PG8_MMA(ai, bj, At, Bt) do { __builtin_amdgcn_s_setprio(1); _Pragma("unroll") for (int m = 0; m < 4; ++m) _Pragma("unroll") for (int n = 0; n < 2; ++n) _Pragma("unroll") for (int k = 0; k < 2; ++k) \
        acc[ai][bj][m][n] = __builtin_amdgcn_mfma_f32_16x16x32_bf16(Bt[n][k], At[m][k], acc[ai][bj][m][n], 0, 0, 0); __builtin_amdgcn_s_setprio(0); } while (0)
#define PG8_WAIT_V(n) asm volatile("s_waitcnt vmcnt(" #n ")" ::: "memory")
#define PG8_WAIT_L(n) asm volatile("s_waitcnt lgkmcnt(" #n ")" ::: "memory")
#define PG8_BAR __builtin_amdgcn_s_barrier()
#define PG8_SCHED __builtin_amdgcn_sched_barrier(0)
    Unit cur, nxt; int ui = 0;
    if (!S.next(0, cur)) return;
    f32x4 acc[2][2][4][2];
#pragma unroll
    for (int a = 0; a < 2; ++a)
#pragma unroll
        for (int b = 0; b < 2; ++b)
#pragma unroll
            for (int m = 0; m < 4; ++m)
#pragma unroll
                for (int n = 0; n < 2; ++n) acc[a][b][m][n] = (f32x4){0.f, 0.f, 0.f, 0.f};
    bf16x8 At[4][2], B0[2][2], B1[2][2];
    const char* cA = (const char*)g.A + (size_t)cur.pm * tstep; const char* cB = (const char*)g.Bt + (size_t)cur.pn * tstep;
    S.a_ready(cur);
    PG8_STAGE(PG8_SB(0, 0), cB, voffB); PG8_STAGE(PG8_SA(0, 0), cA, voffA); PG8_STAGE(PG8_SB(0, 1), cB + hstep, voffB); PG8_STAGE(PG8_SA(0, 1), cA + hstep, voffA);
    if (wr == 1) PG8_BAR;
    PG8_WAIT_V(4); PG8_BAR;
    PG8_STAGE(PG8_SB(1, 0), cB + kstep, voffB); PG8_STAGE(PG8_SA(1, 0), cA + kstep, voffA); PG8_STAGE(PG8_SB(1, 1), cB + hstep + kstep, voffB);
    PG8_WAIT_V(6); PG8_BAR;
    PG8_STAMP();
    for (;;) {
        const bool has_next = S.next(ui + 1, nxt);
        const char* nA = has_next ? (const char*)g.A + (size_t)nxt.pm * tstep : cA; const char* nB = has_next ? (const char*)g.Bt + (size_t)nxt.pn * tstep : cB;
        for (int t = 0; t < nt; t += 2) {
            const bool last = (t == nt - 2);
            const char* a1 = cA + (size_t)(t + 1) * kstep;
            const char* a2 = last ? nA : cA + (size_t)(t + 2) * kstep; const char* b2 = last ? nB : cB + (size_t)(t + 2) * kstep;
            const char* a3 = a2 + kstep; const char* b3 = b2 + kstep;
            if (last && has_next) S.a_ready(nxt);
            PG8_LDB(B0, 0, 0); PG8_SCHED; PG8_LDA(At, 0, 0); PG8_STAGE(PG8_SA(1, 1), a1 + hstep, voffA);
            PG8_WAIT_L(8); PG8_BAR; PG8_WAIT_L(0); PG8_MMA(0, 0, At, B0); PG8_BAR; PG8_SCHED;
            PG8_LDB(B1, 0, 1); PG8_STAGE(PG8_SB(0, 0), b2, voffB);
            PG8_BAR; PG8_WAIT_L(0); PG8_MMA(0, 1, At, B1); PG8_BAR;
            PG8_LDA(At, 0, 1); PG8_STAGE(PG8_SA(0, 0), a2, voffA);
            PG8_BAR; PG8_WAIT_L(0); PG8_MMA(1, 0, At, B0); PG8_BAR; PG8_SCHED;
            PG8_STAGE(PG8_SB(0, 1), b2 + hstep, voffB);
            PG8_WAIT_V(6); PG8_BAR; PG8_MMA(1, 1, At, B1); PG8_BAR;
            PG8_LDB(B0, 1, 0); PG8_SCHED; PG8_LDA(At, 1, 0); PG8_STAGE(PG8_SA(0, 1), a2 + hstep, voffA);
            PG8_WAIT_L(8); PG8_BAR; PG8_WAIT_L(0); PG8_MMA(0, 0, At, B0); PG8_BAR; PG8_SCHED;
            PG8_LDB(B1, 1, 1); PG8_STAGE(PG8_SB(1, 0), b3, voffB);
            PG8_BAR; PG8_WAIT_L(0); PG8_MMA(0, 1, At, B1); PG8_BAR;
            PG8_LDA(At, 1, 1); PG8_STAGE(PG8_SA(1, 0), a3, voffA);
            PG8_BAR; PG8_WAIT_L(0); PG8_MMA(1, 0, At, B0); PG8_BAR; PG8_SCHED;
            PG8_STAGE(PG8_SB(1, 1), b3 + hstep, voffB);
            PG8_WAIT_V(6); PG8_BAR; PG8_MMA(1, 1, At, B1); PG8_BAR;
        }
        PG8_STAMP();
        if constexpr (!Epi::AFTER_DRAIN) { E(acc, cur, wr, wc, fr, fq); S.done(cur); }
        PG8_STAMP();
        if (!has_next) break;
#pragma unroll
        for (int a = 0; a < 2; ++a)
#pragma unroll
            for (int b = 0; b < 2; ++b)
#pragma unroll
                for (int m = 0; m < 4; ++m)
#pragma unroll
                    for (int n = 0; n < 2; ++n) acc[a][b][m][n] = (f32x4){0.f, 0.f, 0.f, 0.f};
        cur = nxt; cA = nA; cB = nB; ++ui;
    }
    PG8_WAIT_V(0);
    if (wr == 0) PG8_BAR;
    PG8_BAR;
    if constexpr (Epi::AFTER_DRAIN) { E.fused(acc, cur, wr, wc, fr, fq, lds, wid, lane); S.done(cur); }
    PG8_STAMP();
    if (STAMP && wid == 0) { stamps[lane] = lane < nts ? (((unsigned long long)(unsigned)ts_hi << 32) | (unsigned)ts_lo) : 0ull;
        if (lane == 62) stamps[62] = rt_entry; if (lane == 63) stamps[63] = (unsigned long long)wall_clock64(); }
#undef PG8_STAMP
#undef PG8_SA
#undef PG8_SB
#undef PG8_STAGE
#undef PG8_LDA
#undef PG8_LDB
#undef PG8_MMA
#undef PG8_WAIT_V
#undef PG8_WAIT_L
#undef PG8_BAR
#undef PG8_SCHED
}
}

using pg8::bf16_t; using pg8::bf16x8; using pg8::f32x4; using pg8::u32x4;

constexpr int DM = 1024, NTOK = 66048, NPROMPT = 65536, INW = 3080, HW = 3072, DFF = 4096;
constexpr int NITEM = 4128;
constexpr float DN_ALPHA = 1.4142135623730951f;
constexpr size_t WS_WIN = 0, WS_WOUT = 12582912, WS_WUP = 16777216, WS_WDN = 33554432, WS_XB = 50331648, WS_LOG = 185597952,
                 WS_ATT = 187711488, WS_GL = 221528064, WS_BIG = 221593600, WS_Y = WS_BIG + 405798912, WS_END = WS_BIG + 541065216, WS_CTL = WS_END, WS_T2 = WS_END + 65536, WS_END2 = WS_T2 + 135266304;
constexpr size_t O_YS = 67108864, O_CONVP = 67633152, O_DELTAP = 67780608, O_CONVS = 69877760, O_DELTAS = 69951488, O_SMLPV = 71000064;
constexpr int LDS_BYTES = 150016;
constexpr int NPHASE = 17;

struct Args { const float* in[22]; float* out; unsigned char* ws; int ph_lo, ph_hi; };
enum { I_XP = 0, I_XS, I_CCONV, I_SDELTA, I_LN0G, I_LN0B, I_WIN, I_CONVW, I_ALOG, I_DTB, I_GNG, I_SLNG, I_SLNB, I_WS, I_BS, I_WOUT, I_LN1G, I_LN1B, I_WUP, I_WDN, I_LN2G, I_LN2B };

__device__ __forceinline__ int opaque_v(int x) { asm volatile("" : "+v"(x)); return x; }
__device__ __forceinline__ int opaque_s(int x) { asm volatile("" : "+s"(x)); return x; }
__device__ __forceinline__ float bf2f(unsigned short b) { return __uint_as_float((unsigned)b << 16); }
__device__ __forceinline__ unsigned pk2(float lo, float hi) { return pg8::cvt_pk_bf16(lo, hi); }
__device__ __forceinline__ unsigned short f2bf(float f) { return (unsigned short)(pk2(f, 0.f) & 0xffffu); }
__device__ __forceinline__ void unpack8(const uint4 v, float* o) {
    o[0] = __uint_as_float(v.x << 16); o[1] = __uint_as_float(v.x & 0xffff0000u); o[2] = __uint_as_float(v.y << 16); o[3] = __uint_as_float(v.y & 0xffff0000u);
    o[4] = __uint_as_float(v.z << 16); o[5] = __uint_as_float(v.z & 0xffff0000u); o[6] = __uint_as_float(v.w << 16); o[7] = __uint_as_float(v.w & 0xffff0000u);
}
__device__ __forceinline__ uint4 pack8(const float* x) { uint4 r; r.x = pk2(x[0], x[1]); r.y = pk2(x[2], x[3]); r.z = pk2(x[4], x[5]); r.w = pk2(x[6], x[7]); return r; }
__device__ __forceinline__ uint2 pack4(const f32x4 v) { uint2 r; r.x = pk2(v[0], v[1]); r.y = pk2(v[2], v[3]); return r; }
template <int CTRL> __device__ __forceinline__ float dpp_mov(float v) { return __builtin_bit_cast(float, __builtin_amdgcn_update_dpp(0, __builtin_bit_cast(int, v), CTRL, 0xf, 0xf, true)); }
__device__ __forceinline__ float sum4(float v) { v += dpp_mov<0xB1>(v); v += dpp_mov<0x4E>(v); return v; }
__device__ __forceinline__ float sum8(float v) { v = sum4(v); v += dpp_mov<0x141>(v); return v; }
__device__ __forceinline__ float sum16(float v) { v = sum8(v); v += dpp_mov<0x140>(v); return v; }
__device__ __forceinline__ float wave_sum(float v) { v = sum16(v); v += __shfl_xor(v, 16); v += __shfl_xor(v, 32); return v; }
__device__ __forceinline__ float gelu_f(float v) {
    const float t = __builtin_amdgcn_rcpf(fabsf(v) * 0.2316418882f + 1.0f);
    float q = t * 0.5307027145f + (-0.7265760135f); q = q * t + 0.7107068705f; q = q * t + (-0.142248368f); q = q * t + 0.127414796f; q = q * t;
    const float e = __builtin_amdgcn_exp2f((v * v) * (-0.72134752044f));
    const float m = v * (q * e);
    return v < 0.f ? m : v - m;
}
__device__ __forceinline__ float silu_f(float x) { return x * __builtin_amdgcn_rcpf(1.0f + __builtin_amdgcn_exp2f(x * (-1.4426950408889634f))); }
__device__ __forceinline__ f32x4 mfma16(const bf16x8 a, const bf16x8 b, const f32x4 c) { return __builtin_amdgcn_mfma_f32_16x16x32_bf16(a, b, c, 0, 0, 0); }

struct EpiAct {
    static constexpr bool PERM = true, AFTER_DRAIN = false;
    bf16_t* O; int ldc; int act;
    __device__ __forceinline__ void operator()(const f32x4 (&acc)[2][2][4][2], const pg8::Unit& u, int wr, int wc, int fr, int fq) const {
        const int row0 = u.pm * 256 + wr * 64 + fr, col0 = u.pn * 256 + wc * 32 + 8 * fq;
#pragma unroll
        for (int ai = 0; ai < 2; ++ai)
#pragma unroll
            for (int m = 0; m < 4; ++m) { bf16_t* rowp = O + (size_t)(row0 + ai * 128 + m * 16) * ldc + col0;
#pragma unroll
                for (int bj = 0; bj < 2; ++bj) { f32x4 v0 = acc[ai][bj][m][0], v1 = acc[ai][bj][m][1];
                    if (act) {
#pragma unroll
                        for (int j = 0; j < 4; ++j) { float p = fmaxf(v0[j], 0.f), q = fmaxf(v1[j], 0.f); v0[j] = p * p; v1[j] = q * q; } }
                    u32x4 w; w.x = pk2(v0[0], v0[1]); w.y = pk2(v0[2], v0[3]); w.z = pk2(v1[0], v1[1]); w.w = pk2(v1[2], v1[3]);
                    *(u32x4*)(rowp + bj * 128) = w; } }
    }
};
struct EpiRes {
    static constexpr bool PERM = true, AFTER_DRAIN = false;
    bf16_t* O; const bf16_t* X;
    __device__ __forceinline__ void operator()(const f32x4 (&acc)[2][2][4][2], const pg8::Unit& u, int wr, int wc, int fr, int fq) const {
        const int row0 = u.pm * 256 + wr * 64 + fr, col0 = u.pn * 256 + wc * 32 + 8 * fq;
#pragma unroll
        for (int ai = 0; ai < 2; ++ai)
#pragma unroll
            for (int m = 0; m < 4; ++m) { const size_t ro = (size_t)(row0 + ai * 128 + m * 16) * DM + col0;
#pragma unroll
                for (int bj = 0; bj < 2; ++bj) { const size_t o = ro + bj * 128; const uint4 xv = *(const uint4*)(X + o);
                    u32x4 w;
                    w.x = pk2(acc[ai][bj][m][0][0] + DN_ALPHA * __uint_as_float(xv.x << 16), acc[ai][bj][m][0][1] + DN_ALPHA * __uint_as_float(xv.x & 0xffff0000u));
                    w.y = pk2(acc[ai][bj][m][0][2] + DN_ALPHA * __uint_as_float(xv.y << 16), acc[ai][bj][m][0][3] + DN_ALPHA * __uint_as_float(xv.y & 0xffff0000u));
                    w.z = pk2(acc[ai][bj][m][1][0] + DN_ALPHA * __uint_as_float(xv.z << 16), acc[ai][bj][m][1][1] + DN_ALPHA * __uint_as_float(xv.z & 0xffff0000u));
                    w.w = pk2(acc[ai][bj][m][1][2] + DN_ALPHA * __uint_as_float(xv.w << 16), acc[ai][bj][m][1][3] + DN_ALPHA * __uint_as_float(xv.w & 0xffff0000u));
                    *(u32x4*)(O + o) = w; __builtin_amdgcn_sched_barrier(0); } }
    }
};

__device__ __forceinline__ void transpose_tile(const float* __restrict__ src, int ld_src, bf16_t* __restrict__ dst, int ld_dst, int k0, int n0s, int n0d, float* tile) {
    const int tidt = opaque_v(threadIdx.x);
    {
        const int c4 = tidt & 15;
#pragma unroll
        for (int i = 0; i < 2; ++i) { const int k = (tidt >> 4) + 32 * i; const float4 v = *(const float4*)(src + (size_t)(k0 + k) * ld_src + n0s + c4 * 4);
            tile[k * 65 + c4 * 4] = v.x; tile[k * 65 + c4 * 4 + 1] = v.y; tile[k * 65 + c4 * 4 + 2] = v.z; tile[k * 65 + c4 * 4 + 3] = v.w; }
    }
    __syncthreads();
    {
        const int n = tidt >> 3, kseg = tidt & 7;
        float t8[8];
#pragma unroll
        for (int i = 0; i < 8; ++i) t8[i] = tile[(kseg * 8 + i) * 65 + n];
        *(uint4*)(dst + (size_t)(n0d + n) * ld_dst + k0 + kseg * 8) = pack8(t8);
    }
    __syncthreads();
}
__device__ __forceinline__ void weights_phase(const Args& a, unsigned char* lds) {
    float* tile = (float*)lds;
    for (int t = opaque_s(blockIdx.x); t < 6144; t += gridDim.x) {
        if (t < 1536) { const int l = t / 768, r = t % 768, kt = r / 48, nt = r % 48; const int n0d = nt * 64, n0s = n0d < 2048 ? n0d : n0d + 8;
            transpose_tile(a.in[I_WIN] + (size_t)l * DM * INW, INW, (bf16_t*)(a.ws + WS_WIN) + (size_t)l * HW * DM, DM, kt * 64, n0s, n0d, tile); }
        else if (t < 2048) { const int q = t - 1536, l = q / 256, r = q % 256, kt = r / 16, nt = r % 16;
            transpose_tile(a.in[I_WOUT] + (size_t)l * DM * DM, DM, (bf16_t*)(a.ws + WS_WOUT) + (size_t)l * DM * DM, DM, kt * 64, nt * 64, nt * 64, tile); }
        else if (t < 4096) { const int q = t - 2048, l = q / 1024, r = q % 1024, kt = r / 64, nt = r % 64;
            transpose_tile(a.in[I_WUP] + (size_t)l * DM * DFF, DFF, (bf16_t*)(a.ws + WS_WUP) + (size_t)l * DFF * DM, DM, kt * 64, nt * 64, nt * 64, tile); }
        else { const int q = t - 4096, l = q / 1024, r = q % 1024, kt = r / 16, nt = r % 16;
            transpose_tile(a.in[I_WDN] + (size_t)l * DFF * DM, DM, (bf16_t*)(a.ws + WS_WDN) + (size_t)l * DM * DFF, DFF, kt * 64, nt * 64, nt * 64, tile); }
    }
}

template <bool SRC_BF16>
__device__ __forceinline__ void ln_phase(const Args& a, unsigned char* lds, const void* srcP, const void* srcS, const float* __restrict__ g, const float* __restrict__ b,
                                         bool f32out, float* dstP, float* dstS, bool logits, int lnext, bool resid = false) {
    const int tid = opaque_v(threadIdx.x), lane = tid & 63, wid = tid >> 6;
    float* wl = (float*)lds;
    if (logits) {
        const float* w = a.in[I_WIN] + (size_t)lnext * DM * INW;
        for (int i = tid; i < 8192; i += 512) { const int k = i >> 3, j = i & 7; wl[j * 1024 + k] = w[(size_t)k * INW + 2048 + j]; }
        __syncthreads();
    }
    bf16_t* xb = (bf16_t*)(a.ws + WS_XB); float* LOG = (float*)(a.ws + WS_LOG);
    float gv[16], bv[16];
#pragma unroll
    for (int i = 0; i < 2; ++i)
#pragma unroll
        for (int e = 0; e < 2; ++e) { const float4 t = *(const float4*)(g + i * 512 + lane * 8 + 4 * e), u = *(const float4*)(b + i * 512 + lane * 8 + 4 * e);
            gv[i * 8 + e * 4] = t.x; gv[i * 8 + e * 4 + 1] = t.y; gv[i * 8 + e * 4 + 2] = t.z; gv[i * 8 + e * 4 + 3] = t.w;
            bv[i * 8 + e * 4] = u.x; bv[i * 8 + e * 4 + 1] = u.y; bv[i * 8 + e * 4 + 2] = u.z; bv[i * 8 + e * 4 + 3] = u.w; }
    uint4 pr0 = make_uint4(0u, 0u, 0u, 0u), pr1 = pr0, px0 = pr0, px1 = pr0;
#define LN_PREFETCH(ROW) do { const size_t ro_ = (ROW) < NPROMPT ? (size_t)(ROW) * DM : (size_t)((ROW) - NPROMPT) * DM; \
        const bf16_t* src_ = ((ROW) < NPROMPT ? (const bf16_t*)srcP : (const bf16_t*)srcS) + ro_; \
        pr0 = *(const uint4*)(src_ + lane * 8); pr1 = *(const uint4*)(src_ + 512 + lane * 8); \
        if (resid) { px0 = *(const uint4*)(xb + (size_t)(ROW) * DM + lane * 8); px1 = *(const uint4*)(xb + (size_t)(ROW) * DM + 512 + lane * 8); } } while (0)
    if (SRC_BF16) { const int row_first = opaque_s(blockIdx.x) * 8 + wid; if (row_first < NTOK) LN_PREFETCH(row_first); }
    for (int row = opaque_s(blockIdx.x) * 8 + wid; row < NTOK; row += gridDim.x * 8) {
        const size_t ro = row < NPROMPT ? (size_t)row * DM : (size_t)(row - NPROMPT) * DM;
        float v[16];
        if (SRC_BF16) {
            const uint4 r0 = pr0, r1 = pr1, x0 = px0, x1 = px1;
            { const int nrow = row + (int)gridDim.x * 8; if (nrow < NTOK) LN_PREFETCH(nrow); }
            unpack8(r0, v); unpack8(r1, v + 8);
            if (resid) {
                float xv[16]; unpack8(x0, xv); unpack8(x1, xv + 8);
#pragma unroll
                for (int i = 0; i < 16; ++i) v[i] += DN_ALPHA * xv[i];
            }
        } else {
            const float* src = (row < NPROMPT ? (const float*)srcP : (const float*)srcS) + ro;
#pragma unroll
            for (int i = 0; i < 2; ++i)
#pragma unroll
                for (int e = 0; e < 2; ++e) { const float4 t = *(const float4*)(src + i * 512 + lane * 8 + 4 * e); v[i * 8 + e * 4] = t.x; v[i * 8 + e * 4 + 1] = t.y; v[i * 8 + e * 4 + 2] = t.z; v[i * 8 + e * 4 + 3] = t.w; }
        }
        float s = 0.f;
#pragma unroll
        for (int i = 0; i < 16; ++i) s += v[i];
        const float mean = wave_sum(s) * (1.0f / 1024.0f);
        float q = 0.f;
#pragma unroll
        for (int i = 0; i < 16; ++i) { v[i] -= mean; q += v[i] * v[i]; }
        const float rstd = rsqrtf(wave_sum(q) * (1.0f / 1024.0f) + 1e-5f);
#pragma unroll
        for (int i = 0; i < 16; ++i) v[i] = v[i] * rstd * gv[i] + bv[i];
        if (!f32out) { *(uint4*)(xb + (size_t)row * DM + lane * 8) = pack8(v); *(uint4*)(xb + (size_t)row * DM + 512 + lane * 8) = pack8(v + 8); }
        if (f32out) { float* dst = (row < NPROMPT ? dstP : dstS) + ro;
#pragma unroll
            for (int i = 0; i < 2; ++i)
#pragma unroll
                for (int e = 0; e < 2; ++e) *(float4*)(dst + i * 512 + lane * 8 + 4 * e) = make_float4(v[i * 8 + e * 4], v[i * 8 + e * 4 + 1], v[i * 8 + e * 4 + 2], v[i * 8 + e * 4 + 3]); }
        if (logits) {
            float p[8];
#pragma unroll
            for (int j = 0; j < 8; ++j) { float q8 = 0.f;
#pragma unroll
                for (int i = 0; i < 2; ++i)
#pragma unroll
                    for (int e = 0; e < 2; ++e) { const float4 w = *(const float4*)(wl + j * 1024 + i * 512 + lane * 8 + 4 * e);
                        q8 += (v[i * 8 + e * 4] * w.x + v[i * 8 + e * 4 + 1] * w.y) + (v[i * 8 + e * 4 + 2] * w.z + v[i * 8 + e * 4 + 3] * w.w); }
                p[j] = q8; }
            const bool b0 = (lane & 1) != 0, b1 = (lane & 2) != 0, b2 = (lane & 4) != 0;
            float k1[4], k2[2], k3;
#pragma unroll
            for (int i = 0; i < 4; ++i) { const float send = b0 ? p[i] : p[4 + i], keep = b0 ? p[4 + i] : p[i]; k1[i] = keep + __shfl_xor(send, 1); }
#pragma unroll
            for (int i = 0; i < 2; ++i) { const float send = b1 ? k1[i] : k1[2 + i], keep = b1 ? k1[2 + i] : k1[i]; k2[i] = keep + __shfl_xor(send, 2); }
            { const float send = b2 ? k2[0] : k2[1], keep = b2 ? k2[1] : k2[0]; k3 = keep + __shfl_xor(send, 4); }
            k3 += __shfl_xor(k3, 8); k3 += __shfl_xor(k3, 16); k3 += __shfl_xor(k3, 32);
            if (lane < 8) LOG[(size_t)row * 8 + ((lane & 1) * 4 + ((lane >> 1) & 1) * 2 + ((lane >> 2) & 1))] = k3;
        }
    }
#undef LN_PREFETCH
    __syncthreads();
}

constexpr int PL_TM = 17408, PL_XM = 34816, PL_G = 39424, PL_CW = 40192, PL_KS = 64768, PL_QS = 82176, PL_VB = 99584, PL_KG = 116992;
#define PREP_PREFETCH(ITEM) do { const int t0_ = ((ITEM) >> 2) * 64, h_ = (ITEM) & 3; \
        _Pragma("unroll") for (int w_ = 0; w_ < 3; ++w_) _Pragma("unroll") for (int j_ = 0; j_ < 4; ++j_) { \
            int row_ = t0_ + r + j_ - 3; row_ = row_ < 0 ? 0 : row_; \
            const uint4* p_ = (const uint4*)(H + (size_t)row_ * HW + w_ * 512 + h_ * 128 + cgi * 16); raw[w_][j_][0] = p_[0]; raw[w_][j_][1] = p_[1]; } } while (0)
__device__ __forceinline__ void gdn_prep_item(const Args& a, unsigned char* lds, int l, int item, int nitem, uint4 (&raw)[3][4][2], float& pbl, float& pal) {
    const int tid = opaque_v(threadIdx.x), lane = tid & 63, wid = tid >> 6, lr = lane & 15, lq = lane >> 4;
    const int c64 = item >> 2, h = item & 3, tok0 = c64 * 64;
    const bool sample = c64 >= 1024;
    const int mode = sample ? 2 : ((c64 & 63) == 0 ? 0 : 1);
    const bf16_t* H = (const bf16_t*)(a.ws + WS_BIG);
    const float* LOG = (const float*)(a.ws + WS_LOG);
    float* Am = (float*)(lds); float* Tm = (float*)(lds + PL_TM); float* Xm = (float*)(lds + PL_XM);
    float* gcs = (float*)(lds + PL_G); float* bts = gcs + 64; float* egs = gcs + 128; const float* cws = (const float*)(lds + PL_CW);
    bf16_t* Ks = (bf16_t*)(lds + PL_KS); bf16_t* Qs = (bf16_t*)(lds + PL_QS); bf16_t* VBs = (bf16_t*)(lds + PL_VB); bf16_t* KGs = (bf16_t*)(lds + PL_KG);
    unsigned char* ib = (unsigned char*)a.out + (size_t)item * 65536;
    bf16_t* NW = (bf16_t*)ib; bf16_t* UF = (bf16_t*)(ib + 16384); bf16_t* QD = (bf16_t*)(ib + 32768); bf16_t* KDT = (bf16_t*)(ib + 49152);
    bf16_t* ATT = (bf16_t*)(a.ws + WS_ATT) + (size_t)item * 4096;
    const int r = tid >> 3, cgi = tid & 7;
    if (wid == 0) {
        const float bl = pbl, al = pal;
        { const int nt0 = (nitem >> 2) * 64, nh = nitem & 3; const float* lg = LOG + (size_t)(nt0 + lane) * 8; pbl = lg[nh]; pal = lg[4 + nh]; }
        const float A = expf(a.in[I_ALOG][l * 4 + h]); const float x = al + a.in[I_DTB][l * 4 + h];
        const float sp = x > 20.f ? x : log1pf(expf(x));
        float g = -A * sp;
#pragma unroll
        for (int o = 1; o < 64; o <<= 1) { const float t = __shfl_up(g, o); if (lane >= o) g += t; }
        const float gl = __shfl(g, 63);
        gcs[lane] = g; bts[lane] = 1.0f / (1.0f + expf(-bl)); egs[lane] = expf(gl - g);
        if (lane == 63) ((float*)(a.ws + WS_GL))[item] = expf(g);
    }
    for (int i = tid; i < 64 * 68; i += 512) Tm[i] = 0.f;
    __syncthreads();
    {
        const float gc = gcs[r], bt = bts[r];
        const float eg = expf(gc);
        const float* cc = a.in[I_CCONV] + (size_t)(l * 8 + (sample ? c64 - 1024 : 0)) * 3 * 1536;
#pragma unroll
        for (int which = 0; which < 3; ++which) {
            const int col = which * 512 + h * 128 + cgi * 16;
            float acc[16];
#pragma unroll
            for (int i = 0; i < 16; ++i) acc[i] = 0.f;
#pragma unroll
            for (int j = 0; j < 4; ++j) {
                const int rr = r + j - 3;
                float x[16];
                unpack8(raw[which][j][0], x); unpack8(raw[which][j][1], x + 8);
                if (rr < 0 && mode != 1) {
                    if (mode == 2) { const float4* p = (const float4*)(cc + (size_t)(rr + 3) * 1536 + col);
#pragma unroll
                        for (int i = 0; i < 4; ++i) { const float4 t = p[i]; x[4 * i] = t.x; x[4 * i + 1] = t.y; x[4 * i + 2] = t.z; x[4 * i + 3] = t.w; } }
                    else {
#pragma unroll
                        for (int i = 0; i < 16; ++i) x[i] = 0.f; }
                }
                const float4* wp = (const float4*)(cws + j * 1536 + col);
#pragma unroll
                for (int i = 0; i < 4; ++i) { const float4 w = wp[i]; acc[4 * i] += x[4 * i] * w.x; acc[4 * i + 1] += x[4 * i + 1] * w.y; acc[4 * i + 2] += x[4 * i + 2] * w.z; acc[4 * i + 3] += x[4 * i + 3] * w.w; }
            }
#pragma unroll
            for (int i = 0; i < 16; ++i) acc[i] = silu_f(acc[i]);
            if (which < 2) {
                float ss = 0.f;
#pragma unroll
                for (int i = 0; i < 16; ++i) ss += acc[i] * acc[i];
                ss = sum8(ss);
                const float sc = rsqrtf(ss + 1e-6f) * (which == 0 ? 0.08838834764831845f : 1.0f);
#pragma unroll
                for (int i = 0; i < 16; ++i) acc[i] *= sc;
            }
            float t[16];
            if (which == 0) {
                *(uint4*)(Qs + r * 136 + cgi * 16) = pack8(acc); *(uint4*)(Qs + r * 136 + cgi * 16 + 8) = pack8(acc + 8);
#pragma unroll
                for (int i = 0; i < 16; ++i) t[i] = acc[i] * eg;
                *(uint4*)(QD + r * 128 + cgi * 16) = pack8(t); *(uint4*)(QD + r * 128 + cgi * 16 + 8) = pack8(t + 8);
            } else if (which == 1) {
                *(uint4*)(Ks + r * 136 + cgi * 16) = pack8(acc); *(uint4*)(Ks + r * 136 + cgi * 16 + 8) = pack8(acc + 8);
                const float f = bt * eg;
#pragma unroll
                for (int i = 0; i < 16; ++i) t[i] = acc[i] * f;
                *(uint4*)(KGs + r * 136 + cgi * 16) = pack8(t); *(uint4*)(KGs + r * 136 + cgi * 16 + 8) = pack8(t + 8);
            } else {
#pragma unroll
                for (int i = 0; i < 16; ++i) t[i] = acc[i] * bt;
                *(uint4*)(VBs + r * 136 + cgi * 16) = pack8(t); *(uint4*)(VBs + r * 136 + cgi * 16 + 8) = pack8(t + 8);
            }
        }
        PREP_PREFETCH(nitem);
    }
    __syncthreads();
    {
        const int d = tid >> 2, seg = tid & 3;
        float t[16];
#pragma unroll
        for (int i = 0; i < 16; ++i) t[i] = bf2f(Ks[(seg * 16 + i) * 136 + d]) * egs[seg * 16 + i];
        *(uint4*)(KDT + d * 64 + seg * 16) = pack8(t); *(uint4*)(KDT + d * 64 + seg * 16 + 8) = pack8(t + 8);
    }
#pragma unroll
    for (int jt = 0; jt < 4; ++jt) {
        const int which = wid >> 2, it = wid & 3;
        f32x4 c = {0.f, 0.f, 0.f, 0.f};
        if (jt <= it) {
            const bf16_t* Bs = which ? Qs : Ks;
#pragma unroll
            for (int ks = 0; ks < 4; ++ks) {
                const bf16x8 af = *(const bf16x8*)(Ks + (16 * jt + lr) * 136 + 32 * ks + 8 * lq);
                const bf16x8 bf = *(const bf16x8*)(Bs + (16 * it + lr) * 136 + 32 * ks + 8 * lq);
                c = mfma16(af, bf, c);
            }
        }
        const int i = 16 * it + lr, j0 = 16 * jt + 4 * lq;
        const float gi = gcs[i];
        const float4 gj = *(const float4*)(gcs + j0);
        const float gjv[4] = {gj.x, gj.y, gj.z, gj.w};
        float v[4];
        if (which == 0) {
            const float bi = bts[i];
#pragma unroll
            for (int x = 0; x < 4; ++x) v[x] = (i > j0 + x) ? bi * c[x] * __expf(gi - gjv[x]) : 0.f;
            *(float4*)(Am + i * 68 + j0) = make_float4(v[0], v[1], v[2], v[3]);
        } else {
#pragma unroll
            for (int x = 0; x < 4; ++x) v[x] = (i >= j0 + x) ? c[x] * __expf(gi - gjv[x]) : 0.f;
            uint2 p; p.x = pk2(v[0], v[1]); p.y = pk2(v[2], v[3]);
            *(uint2*)(ATT + i * 64 + j0) = p;
        }
    }
    __syncthreads();
    if (wid == 0) {
        const int b = lane >> 4, c = lane & 15;
        float t[16];
#pragma unroll
        for (int i = 0; i < 16; ++i) t[i] = 0.f;
#pragma unroll
        for (int i = 0; i < 16; ++i) {
            float s = (i == c) ? 1.0f : 0.0f;
#pragma unroll
            for (int jq = 0; jq < (i + 3) / 4; ++jq) {
                const float4 a4 = *(const float4*)(Am + (16 * b + i) * 68 + 16 * b + 4 * jq);
                s -= a4.x * t[4 * jq]; s -= a4.y * t[4 * jq + 1]; s -= a4.z * t[4 * jq + 2]; s -= a4.w * t[4 * jq + 3];
            }
            t[i] = s;
            Tm[(16 * b + i) * 68 + 16 * b + c] = s;
        }
    }
    __syncthreads();
    {
        const int p = tid >> 8, i = (tid >> 4) & 15, j = tid & 15, r0 = 16 + 32 * p, c0 = 32 * p;
        float s = 0.f;
#pragma unroll
        for (int kq = 0; kq < 4; ++kq) { const float4 a4 = *(const float4*)(Am + (r0 + i) * 68 + c0 + 4 * kq);
            s += a4.x * Tm[(c0 + 4 * kq) * 68 + c0 + j]; s += a4.y * Tm[(c0 + 4 * kq + 1) * 68 + c0 + j]; s += a4.z * Tm[(c0 + 4 * kq + 2) * 68 + c0 + j]; s += a4.w * Tm[(c0 + 4 * kq + 3) * 68 + c0 + j]; }
        Xm[(p * 16 + i) * 36 + j] = s;
        __syncthreads();
        float u = 0.f;
#pragma unroll
        for (int kq = 0; kq < 4; ++kq) { const float4 t4 = *(const float4*)(Tm + (r0 + i) * 68 + r0 + 4 * kq);
            u += t4.x * Xm[(p * 16 + 4 * kq) * 36 + j]; u += t4.y * Xm[(p * 16 + 4 * kq + 1) * 36 + j]; u += t4.z * Xm[(p * 16 + 4 * kq + 2) * 36 + j]; u += t4.w * Xm[(p * 16 + 4 * kq + 3) * 36 + j]; }
        Tm[(r0 + i) * 68 + c0 + j] = -u;
    }
    __syncthreads();
    {
        const int i = tid >> 4, j0 = (tid & 15) * 2;
        float s0 = 0.f, s1 = 0.f;
#pragma unroll
        for (int kq = 0; kq < 8; ++kq) { const float4 a4 = *(const float4*)(Am + (32 + i) * 68 + 4 * kq);
            const float av[4] = {a4.x, a4.y, a4.z, a4.w};
#pragma unroll
            for (int e = 0; e < 4; ++e) { const float2 tv = *(const float2*)(Tm + (4 * kq + e) * 68 + j0); s0 += av[e] * tv.x; s1 += av[e] * tv.y; } }
        *(float2*)(Xm + i * 36 + j0) = make_float2(s0, s1);
        __syncthreads();
        float u0 = 0.f, u1 = 0.f;
#pragma unroll
        for (int kq = 0; kq < 8; ++kq) { const float4 t4 = *(const float4*)(Tm + (32 + i) * 68 + 32 + 4 * kq);
            const float tv4[4] = {t4.x, t4.y, t4.z, t4.w};
#pragma unroll
            for (int e = 0; e < 4; ++e) { const float2 xv = *(const float2*)(Xm + (4 * kq + e) * 36 + j0); u0 += tv4[e] * xv.x; u1 += tv4[e] * xv.y; } }
        *(float2*)(Tm + (32 + i) * 68 + j0) = make_float2(-u0, -u1);
    }
    __syncthreads();
    {
        bf16x8 tf[4][2];
#pragma unroll
        for (int rt = 0; rt < 4; ++rt)
#pragma unroll
            for (int ks = 0; ks < 2; ++ks) {
                const float4 t0 = *(const float4*)(Tm + (16 * rt + lr) * 68 + 32 * ks + 8 * lq), t1 = *(const float4*)(Tm + (16 * rt + lr) * 68 + 32 * ks + 8 * lq + 4);
                const unsigned p0 = pk2(t0.x, t0.y), p1 = pk2(t0.z, t0.w), p2 = pk2(t1.x, t1.y), p3 = pk2(t1.z, t1.w);
                bf16x8 f; f[0] = (short)(p0 & 0xffff); f[1] = (short)(p0 >> 16); f[2] = (short)(p1 & 0xffff); f[3] = (short)(p1 >> 16);
                f[4] = (short)(p2 & 0xffff); f[5] = (short)(p2 >> 16); f[6] = (short)(p3 & 0xffff); f[7] = (short)(p3 >> 16);
                tf[rt][ks] = f;
            }
#pragma unroll
        for (int mat = 0; mat < 2; ++mat) {
            const bf16_t* X = mat ? KGs : VBs;
            f32x4 c[4];
#pragma unroll
            for (int rt = 0; rt < 4; ++rt) c[rt] = (f32x4){0.f, 0.f, 0.f, 0.f};
#pragma unroll
            for (int ks = 0; ks < 2; ++ks) {
                bf16x8 xf;
#pragma unroll
                for (int jj = 0; jj < 8; ++jj) xf[jj] = (short)X[(32 * ks + 8 * lq + jj) * 136 + 16 * wid + lr];
#pragma unroll
                for (int rt = 0; rt < 4; ++rt) c[rt] = mat ? mfma16(xf, tf[rt][ks], c[rt]) : mfma16(tf[rt][ks], xf, c[rt]);
            }
            if (mat == 0) {
#pragma unroll
                for (int rt = 0; rt < 4; ++rt) *(uint2*)(UF + ((rt * 8 + wid) * 64 + lane) * 4) = pack4(c[rt]);
            } else {
#pragma unroll
                for (int rt = 0; rt < 4; ++rt) { const f32x4 n = -c[rt]; *(uint2*)(NW + (16 * rt + lr) * 128 + 16 * wid + 4 * lq) = pack4(n); }
            }
        }
    }
    __syncthreads();
}

__device__ __forceinline__ void prep_phase(const Args& a, unsigned char* lds, int l) {
    l = opaque_s(l);
    {
        const int tid = opaque_v(threadIdx.x);
        const float4* src = (const float4*)(a.in[I_CONVW] + (size_t)l * 4 * 1536); float4* dst = (float4*)(lds + PL_CW);
        for (int i = tid; i < 1536; i += 512) dst[i] = src[i];
        __syncthreads();
    }
    {
        const int tid = opaque_v(threadIdx.x), lane = tid & 63, r = tid >> 3, cgi = tid & 7;
        const bf16_t* H = (const bf16_t*)(a.ws + WS_BIG);
        uint4 raw[3][4][2]; float pbl = 0.f, pal = 0.f;
        int item = opaque_s(blockIdx.x);
        if (item < NITEM) {
            PREP_PREFETCH(item);
            if (tid < 64) { const float* lg = (const float*)(a.ws + WS_LOG) + (size_t)((item >> 2) * 64 + lane) * 8; pbl = lg[item & 3]; pal = lg[4 + (item & 3)]; }
        }
        for (; item < NITEM; item += gridDim.x) { const int nx = item + (int)gridDim.x; gdn_prep_item(a, lds, l, item, nx < NITEM ? nx : item, raw, pbl, pal); }
    }
    const bf16_t* H = (const bf16_t*)(a.ws + WS_BIG);
    for (int i = opaque_s(blockIdx.x) * 512 + opaque_v(threadIdx.x); i < 24 * 3 * 1536; i += gridDim.x * 512) {
        const int col = i % 1536, j = (i / 1536) % 3, s = i / 4608;
        if (s < 16) a.out[O_CONVP + ((size_t)(l * 16 + s) * 3 + j) * 1536 + col] = bf2f(H[(size_t)(s * 4096 + 4093 + j) * HW + col]);
        else a.out[O_CONVS + ((size_t)(l * 8 + (s - 16)) * 3 + j) * 1536 + col] = bf2f(H[(size_t)(NPROMPT + (s - 16) * 64 + 61 + j) * HW + col]);
    }
    __syncthreads();
}

__device__ __forceinline__ void scan_item(const Args& a, unsigned char* lds, int l, int sidx) {
    const int tid = opaque_v(threadIdx.x), lane = tid & 63, wid = tid >> 6, lr = lane & 15, lq = lane >> 4;
    const int wr = wid >> 2, wc = wid & 3;
    const bool sample = sidx >= 64;
    const int b = sample ? (sidx - 64) >> 2 : sidx >> 2, h = sidx & 3, nch = sample ? 1 : 64, c64_0 = sample ? 1024 + b : b * 64;
    bf16_t* ST = (bf16_t*)lds; bf16_t* VNT = (bf16_t*)(lds + 34816); bf16_t* NWs = (bf16_t*)(lds + 53248); bf16_t* QDs = (bf16_t*)(lds + 70656);
    bf16_t* KDTs = (bf16_t*)(lds + 88064); bf16_t* ATs = (bf16_t*)(lds + 106496); float* OB = (float*)(lds + 115712);
    const bf16_t* H = (const bf16_t*)(a.ws + WS_BIG); bf16_t* Y = (bf16_t*)(a.ws + WS_Y);
    const float* GL = (const float*)(a.ws + WS_GL);
    f32x4 aS[4][2];
    if (sample) {
        const float* s0 = a.in[I_SDELTA] + (size_t)((l * 8 + b) * 4 + h) * 16384;
#pragma unroll
        for (int dt = 0; dt < 4; ++dt)
#pragma unroll
            for (int et = 0; et < 2; ++et) {
#pragma unroll
                for (int x = 0; x < 4; ++x) aS[dt][et][x] = s0[(16 * (4 * wr + dt) + 4 * lq + x) * 128 + 16 * (2 * wc + et) + lr];
                *(uint2*)(ST + (16 * (2 * wc + et) + lr) * 136 + 16 * (4 * wr + dt) + 4 * lq) = pack4(aS[dt][et]);
            }
    } else {
#pragma unroll
        for (int dt = 0; dt < 4; ++dt)
#pragma unroll
            for (int et = 0; et < 2; ++et) { aS[dt][et] = (f32x4){0.f, 0.f, 0.f, 0.f}; *(uint2*)(ST + (16 * (2 * wc + et) + lr) * 136 + 16 * (4 * wr + dt) + 4 * lq) = make_uint2(0u, 0u); }
    }
    uint4 pf0, pf1, pf2, pf3, pf4, pf5, pf6; uint2 uf0, uf1, uf2, uf3; float gl;
#define SCAN_LOAD_NW(ITEM) do { const unsigned char* ib_ = (const unsigned char*)a.out + (size_t)(ITEM) * 65536; \
        pf0 = *(const uint4*)(ib_ + (size_t)tid * 16); pf1 = *(const uint4*)(ib_ + (size_t)(tid + 512) * 16); } while (0)
#define SCAN_LOAD(ITEM) do { const unsigned char* ib_ = (const unsigned char*)a.out + (size_t)(ITEM) * 65536; \
        pf2 = *(const uint4*)(ib_ + 32768 + (size_t)tid * 16); pf3 = *(const uint4*)(ib_ + 32768 + (size_t)(tid + 512) * 16); \
        pf4 = *(const uint4*)(ib_ + 49152 + (size_t)tid * 16); pf5 = *(const uint4*)(ib_ + 49152 + (size_t)(tid + 512) * 16); \
        pf6 = *(const uint4*)((const unsigned char*)(a.ws + WS_ATT) + (size_t)(ITEM) * 8192 + (size_t)tid * 16); \
        uf0 = *(const uint2*)(ib_ + 16384 + (size_t)(((2 * wr + 0) * 8 + 2 * wc + 0) * 64 + lane) * 8); \
        uf1 = *(const uint2*)(ib_ + 16384 + (size_t)(((2 * wr + 0) * 8 + 2 * wc + 1) * 64 + lane) * 8); \
        uf2 = *(const uint2*)(ib_ + 16384 + (size_t)(((2 * wr + 1) * 8 + 2 * wc + 0) * 64 + lane) * 8); \
        uf3 = *(const uint2*)(ib_ + 16384 + (size_t)(((2 * wr + 1) * 8 + 2 * wc + 1) * 64 + lane) * 8); \
        gl = GL[ITEM]; } while (0)
#define SCAN_STORE_NW() do { \
        *(uint4*)((unsigned char*)NWs + (tid >> 4) * 272 + (tid & 15) * 16) = pf0; *(uint4*)((unsigned char*)NWs + ((tid + 512) >> 4) * 272 + (tid & 15) * 16) = pf1; } while (0)
#define SCAN_STORE() do { \
        *(uint4*)((unsigned char*)QDs + (tid >> 4) * 272 + (tid & 15) * 16) = pf2; *(uint4*)((unsigned char*)QDs + ((tid + 512) >> 4) * 272 + (tid & 15) * 16) = pf3; \
        *(uint4*)((unsigned char*)KDTs + (tid >> 3) * 144 + (tid & 7) * 16) = pf4; *(uint4*)((unsigned char*)KDTs + ((tid + 512) >> 3) * 144 + (tid & 7) * 16) = pf5; \
        *(uint4*)((unsigned char*)ATs + (tid >> 3) * 144 + (tid & 7) * 16) = pf6; } while (0)
    SCAN_LOAD_NW((c64_0) * 4 + h); SCAN_LOAD((c64_0) * 4 + h);
    SCAN_STORE_NW(); SCAN_STORE();
    { const int n1 = nch > 1 ? 1 : 0; SCAN_LOAD_NW((c64_0 + n1) * 4 + h); }
    f32x4 av[2][2];
#define UF2AV(CT, ET, U) do { av[CT][ET][0] = __uint_as_float(U.x << 16); av[CT][ET][1] = __uint_as_float(U.x & 0xffff0000u); av[CT][ET][2] = __uint_as_float(U.y << 16); av[CT][ET][3] = __uint_as_float(U.y & 0xffff0000u); } while (0)
    UF2AV(0, 0, uf0); UF2AV(0, 1, uf1); UF2AV(1, 0, uf2); UF2AV(1, 1, uf3);
    float glc = gl;
    __syncthreads();
    const int r = tid >> 3, cgi = tid & 7;
    float* NGs = (float*)(lds + 149504);
    if (tid < 128) NGs[tid] = a.in[I_GNG][l * 128 + tid];
    __syncthreads();
    for (int n = 0; n < nch; ++n) {
        const int tok0 = (c64_0 + n) * 64;
        { const int nn = (n + 1 < nch) ? n + 1 : n; SCAN_LOAD((c64_0 + nn) * 4 + h); }
        bf16x8 sfr[4][2], qf[4][2];
        {
            bf16x8 nwf[4][2];
#pragma unroll
            for (int ks = 0; ks < 4; ++ks) {
#pragma unroll
                for (int et = 0; et < 2; ++et) sfr[ks][et] = *(const bf16x8*)(ST + (16 * (2 * wc + et) + lr) * 136 + 32 * ks + 8 * lq);
#pragma unroll
                for (int ct = 0; ct < 2; ++ct) nwf[ks][ct] = *(const bf16x8*)(NWs + (16 * (2 * wr + ct) + lr) * 136 + 32 * ks + 8 * lq);
            }
#pragma unroll
            for (int ks = 0; ks < 4; ++ks)
#pragma unroll
                for (int ct = 0; ct < 2; ++ct) qf[ks][ct] = *(const bf16x8*)(QDs + (16 * (2 * wr + ct) + lr) * 136 + 32 * ks + 8 * lq);
            __builtin_amdgcn_sched_barrier(0);
#pragma unroll
            for (int ks = 0; ks < 4; ++ks)
#pragma unroll
                for (int ct = 0; ct < 2; ++ct)
#pragma unroll
                    for (int et = 0; et < 2; ++et) av[ct][et] = mfma16(nwf[ks][ct], sfr[ks][et], av[ct][et]);
        }
#pragma unroll
        for (int ct = 0; ct < 2; ++ct)
#pragma unroll
            for (int et = 0; et < 2; ++et) *(uint2*)(VNT + (16 * (2 * wc + et) + lr) * 72 + 16 * (2 * wr + ct) + 4 * lq) = pack4(av[ct][et]);
        __syncthreads();
        SCAN_STORE_NW();
        { const int n2 = (n + 2 < nch) ? n + 2 : nch - 1; SCAN_LOAD_NW((c64_0 + n2) * 4 + h); }
        const uint4* zp = (const uint4*)(H + (size_t)(tok0 + r) * HW + 1536 + h * 128 + cgi * 16);
        const uint4 z0 = zp[0], z1 = zp[1];
        f32x4 ao[2][2];
#pragma unroll
        for (int ct = 0; ct < 2; ++ct)
#pragma unroll
            for (int et = 0; et < 2; ++et) ao[ct][et] = (f32x4){0.f, 0.f, 0.f, 0.f};
        {
            bf16x8 vf0[2], at0[2], kf0[4], vf1[2], at1[2], kf1[4];
#pragma unroll
            for (int et = 0; et < 2; ++et) vf0[et] = *(const bf16x8*)(VNT + (16 * (2 * wc + et) + lr) * 72 + 8 * lq);
#pragma unroll
            for (int ct = 0; ct < 2; ++ct) at0[ct] = *(const bf16x8*)(ATs + (16 * (2 * wr + ct) + lr) * 72 + 8 * lq);
#pragma unroll
            for (int dt = 0; dt < 4; ++dt) kf0[dt] = *(const bf16x8*)(KDTs + (16 * (4 * wr + dt) + lr) * 72 + 8 * lq);
            __builtin_amdgcn_sched_barrier(0);
#pragma unroll
            for (int ks = 0; ks < 4; ++ks)
#pragma unroll
                for (int ct = 0; ct < 2; ++ct)
#pragma unroll
                    for (int et = 0; et < 2; ++et) ao[ct][et] = mfma16(sfr[ks][et], qf[ks][ct], ao[ct][et]);
#pragma unroll
            for (int dt = 0; dt < 4; ++dt)
#pragma unroll
                for (int et = 0; et < 2; ++et) aS[dt][et] *= glc;
#pragma unroll
            for (int et = 0; et < 2; ++et) vf1[et] = *(const bf16x8*)(VNT + (16 * (2 * wc + et) + lr) * 72 + 32 + 8 * lq);
#pragma unroll
            for (int ct = 0; ct < 2; ++ct) at1[ct] = *(const bf16x8*)(ATs + (16 * (2 * wr + ct) + lr) * 72 + 32 + 8 * lq);
#pragma unroll
            for (int dt = 0; dt < 4; ++dt) kf1[dt] = *(const bf16x8*)(KDTs + (16 * (4 * wr + dt) + lr) * 72 + 32 + 8 * lq);
            __builtin_amdgcn_sched_barrier(0);
#pragma unroll
            for (int ct = 0; ct < 2; ++ct)
#pragma unroll
                for (int et = 0; et < 2; ++et) ao[ct][et] = mfma16(vf0[et], at0[ct], ao[ct][et]);
#pragma unroll
            for (int dt = 0; dt < 4; ++dt)
#pragma unroll
                for (int et = 0; et < 2; ++et) aS[dt][et] = mfma16(kf0[dt], vf0[et], aS[dt][et]);
#pragma unroll
            for (int ct = 0; ct < 2; ++ct)
#pragma unroll
                for (int et = 0; et < 2; ++et) ao[ct][et] = mfma16(vf1[et], at1[ct], ao[ct][et]);
#pragma unroll
            for (int dt = 0; dt < 4; ++dt)
#pragma unroll
                for (int et = 0; et < 2; ++et) aS[dt][et] = mfma16(kf1[dt], vf1[et], aS[dt][et]);
            __builtin_amdgcn_sched_barrier(0);
        }
#pragma unroll
        for (int ct = 0; ct < 2; ++ct)
#pragma unroll
            for (int et = 0; et < 2; ++et) *(float4*)(OB + (16 * (2 * wr + ct) + lr) * 132 + 16 * (2 * wc + et) + 4 * lq) = make_float4(ao[ct][et][0], ao[ct][et][1], ao[ct][et][2], ao[ct][et][3]);
        __syncthreads();
        SCAN_STORE();
        UF2AV(0, 0, uf0); UF2AV(0, 1, uf1); UF2AV(1, 0, uf2); UF2AV(1, 1, uf3);
        asm volatile("" : "+v"(gl));
        glc = gl;
#pragma unroll
        for (int dt = 0; dt < 4; ++dt)
#pragma unroll
            for (int et = 0; et < 2; ++et) *(uint2*)(ST + (16 * (2 * wc + et) + lr) * 136 + 16 * (4 * wr + dt) + 4 * lq) = pack4(aS[dt][et]);
        {
            float o[16], z[16];
#pragma unroll
            for (int i = 0; i < 4; ++i) { const float4 t = *(const float4*)(OB + r * 132 + cgi * 16 + 4 * i); o[4 * i] = t.x; o[4 * i + 1] = t.y; o[4 * i + 2] = t.z; o[4 * i + 3] = t.w; }
            float ss = 0.f;
#pragma unroll
            for (int i = 0; i < 16; ++i) ss += o[i] * o[i];
            ss = sum8(ss);
            const float rs = rsqrtf(ss * (1.0f / 128.0f) + 1e-6f);
            unpack8(z0, z); unpack8(z1, z + 8);
            float ng[16];
#pragma unroll
            for (int i = 0; i < 4; ++i) { const float4 t = *(const float4*)(NGs + cgi * 16 + 4 * i); ng[4 * i] = t.x; ng[4 * i + 1] = t.y; ng[4 * i + 2] = t.z; ng[4 * i + 3] = t.w; }
#pragma unroll
            for (int i = 0; i < 16; ++i) o[i] = o[i] * rs * ng[i] * silu_f(z[i]);
            bf16_t* yp = Y + (size_t)(tok0 + r) * DM + h * 128 + cgi * 16;
            *(uint4*)yp = pack8(o); *(uint4*)(yp + 8) = pack8(o + 8);
        }
        __syncthreads();
    }
#undef SCAN_LOAD
#undef SCAN_LOAD_NW
#undef SCAN_STORE_NW
#undef UF2AV
#undef SCAN_STORE
    float* so = a.out + (sample ? O_DELTAS + (size_t)((l * 8 + b) * 4 + h) * 16384 : O_DELTAP + (size_t)((l * 16 + b) * 4 + h) * 16384);
#pragma unroll
    for (int dt = 0; dt < 4; ++dt)
#pragma unroll
        for (int et = 0; et < 2; ++et)
#pragma unroll
            for (int x = 0; x < 4; ++x) so[(16 * (4 * wr + dt) + 4 * lq + x) * 128 + 16 * (2 * wc + et) + lr] = aS[dt][et][x];
    __syncthreads();
}

template <int NT>
__device__ __forceinline__ void smlp_item(const Args& a, unsigned char* lds, int l, int tok0, float* vout) {
    constexpr int NRT = NT / 16, NKS = NT / 32;
    const int tid = opaque_v(threadIdx.x), lane = tid & 63, wid = tid >> 6, lr = lane & 15, lq = lane >> 4;
    bf16_t* Vn = (bf16_t*)lds;
    const bf16_t* H = (const bf16_t*)(a.ws + WS_BIG); bf16_t* Y = (bf16_t*)(a.ws + WS_Y);
    {
        const float* lg = a.in[I_SLNG] + l * 512 + lane * 8; const float* lb = a.in[I_SLNB] + l * 512 + lane * 8;
        float g8[8], b8[8];
#pragma unroll
        for (int i = 0; i < 8; ++i) { g8[i] = lg[i]; b8[i] = lb[i]; }
        for (int q0 = wid; q0 < NT; q0 += 32) {
            uint4 raw[4];
#pragma unroll
            for (int u = 0; u < 4; ++u) raw[u] = *(const uint4*)(H + (size_t)(tok0 + q0 + 8 * u) * HW + 2560 + lane * 8);
            float x[4][8], sm[4], qq[4];
#pragma unroll
            for (int u = 0; u < 4; ++u) { unpack8(raw[u], x[u]); sm[u] = 0.f;
#pragma unroll
                for (int i = 0; i < 8; ++i) { x[u][i] = gelu_f(x[u][i]); sm[u] += x[u][i]; } }
#pragma unroll
            for (int u = 0; u < 4; ++u) sm[u] = wave_sum(sm[u]);
#pragma unroll
            for (int u = 0; u < 4; ++u) { const float mean = sm[u] * (1.0f / 512.0f); qq[u] = 0.f;
#pragma unroll
                for (int i = 0; i < 8; ++i) { x[u][i] -= mean; qq[u] += x[u][i] * x[u][i]; } }
#pragma unroll
            for (int u = 0; u < 4; ++u) qq[u] = wave_sum(qq[u]);
#pragma unroll
            for (int u = 0; u < 4; ++u) { const int q = q0 + 8 * u; const float rstd = rsqrtf(qq[u] * (1.0f / 512.0f) + 1e-5f);
#pragma unroll
                for (int i = 0; i < 8; ++i) x[u][i] = x[u][i] * rstd * g8[i] + b8[i];
                *(uint4*)(Vn + q * 520 + lane * 8) = pack8(x[u]);
                if (vout) { float* vp = vout + (size_t)q * 512 + lane * 8; *(float4*)vp = make_float4(x[u][0], x[u][1], x[u][2], x[u][3]); *(float4*)(vp + 4) = make_float4(x[u][4], x[u][5], x[u][6], x[u][7]); } }
        }
    }
    __syncthreads();
    {
        const int g = wid >> 1, ch = wid & 1;
        bf16x8 bfr[NKS][4];
#pragma unroll
        for (int ks = 0; ks < NKS; ++ks)
#pragma unroll
            for (int ct = 0; ct < 4; ++ct)
#pragma unroll
                for (int jj = 0; jj < 8; ++jj) bfr[ks][ct][jj] = (short)Vn[(32 * ks + 8 * lq + jj) * 520 + g * 128 + 16 * (ch * 4 + ct) + lr];
        const float* Wg = a.in[I_WS] + (size_t)(l * 4 + g) * 16384; const float* bsg = a.in[I_BS] + (l * 4 + g) * 128;
#pragma unroll 1
        for (int rt = 0; rt < NRT; ++rt) {
            f32x4 c[4];
#pragma unroll
            for (int ct = 0; ct < 4; ++ct) c[ct] = (f32x4){0.f, 0.f, 0.f, 0.f};
#pragma unroll
            for (int ks = 0; ks < NKS; ++ks) {
                if (ks <= rt / 2) {
                    const int p = 16 * rt + lr, q0 = 32 * ks + 8 * lq;
                    const float4 w0 = *(const float4*)(Wg + p * 128 + q0), w1 = *(const float4*)(Wg + p * 128 + q0 + 4);
                    float w[8] = {w0.x, w0.y, w0.z, w0.w, w1.x, w1.y, w1.z, w1.w};
#pragma unroll
                    for (int jj = 0; jj < 8; ++jj) w[jj] = (q0 + jj <= p) ? w[jj] : 0.f;
                    const uint4 pk = pack8(w);
                    bf16x8 af; af[0] = (short)(pk.x & 0xffff); af[1] = (short)(pk.x >> 16); af[2] = (short)(pk.y & 0xffff); af[3] = (short)(pk.y >> 16);
                    af[4] = (short)(pk.z & 0xffff); af[5] = (short)(pk.z >> 16); af[6] = (short)(pk.w & 0xffff); af[7] = (short)(pk.w >> 16);
#pragma unroll
                    for (int ct = 0; ct < 4; ++ct) c[ct] = mfma16(bfr[ks][ct], af, c[ct]);
                }
            }
            {
                const int p = 16 * rt + lr; const float bsp = bsg[p];
                uint2 uv[4];
#pragma unroll
                for (int ct = 0; ct < 4; ++ct) uv[ct] = *(const uint2*)(H + (size_t)(tok0 + p) * HW + 2048 + g * 128 + 16 * (ch * 4 + ct) + 4 * lq);
#pragma unroll
                for (int ct = 0; ct < 4; ++ct) {
                    const float u0 = gelu_f(__uint_as_float(uv[ct].x << 16)), u1 = gelu_f(__uint_as_float(uv[ct].x & 0xffff0000u)), u2 = gelu_f(__uint_as_float(uv[ct].y << 16)), u3 = gelu_f(__uint_as_float(uv[ct].y & 0xffff0000u));
                    uint2 yv; yv.x = pk2(u0 * (c[ct][0] + bsp), u1 * (c[ct][1] + bsp)); yv.y = pk2(u2 * (c[ct][2] + bsp), u3 * (c[ct][3] + bsp));
                    *(uint2*)(Y + (size_t)(tok0 + p) * DM + 512 + g * 128 + 16 * (ch * 4 + ct) + 4 * lq) = yv;
                }
            }
        }
    }
    __syncthreads();
}

__device__ __forceinline__ void scan_phase(const Args& a, unsigned char* lds, int l) {
    const int bid = opaque_s(blockIdx.x); l = opaque_s(l);
#ifndef NO_SCAN
    if (bid < 96) scan_item(a, lds, l, bid);
#endif
#ifndef NO_SMLP
    if (bid >= 64) {
        for (int rep = 0; rep < (REP_K == 3 ? 2 : 1); ++rep)
        for (int j = bid - 64; j < 520; j += gridDim.x - 64) {
            if (j < 512) smlp_item<128>(a, lds, l, j * 128, nullptr);
            else smlp_item<64>(a, lds, l, NPROMPT + (j - 512) * 64, a.out + O_SMLPV + (size_t)(l * 8 + (j - 512)) * 64 * 512);
        }
    }
#endif
}

__device__ __forceinline__ void small_gemm_phase(unsigned char* lds, const bf16_t* __restrict__ A, const bf16_t* __restrict__ Bt, int N, int K, bf16_t* O, int ldc, int mode, const bf16_t* X) {
    const int tid = opaque_v(threadIdx.x), lane = tid & 63, wid = tid >> 6, lr = lane & 15, lq = lane >> 4;
    const int ntiles = 16 * (N >> 6), Ks = K >> 3, nks = Ks >> 5;
    float* P = (float*)lds;
    for (int t = opaque_s(blockIdx.x); t < ntiles; t += gridDim.x) {
        const int mt = t & 15, nt = t >> 4, row0 = NPROMPT + mt * 32, col0 = nt * 64;
        f32x4 acc[2][4];
#pragma unroll
        for (int i = 0; i < 2; ++i)
#pragma unroll
            for (int j = 0; j < 4; ++j) acc[i][j] = (f32x4){0.f, 0.f, 0.f, 0.f};
        const bf16_t* ap = A + (size_t)(row0 + lr) * K + wid * Ks + 8 * lq;
        const bf16_t* bp = Bt + (size_t)(col0 + lr) * K + wid * Ks + 8 * lq;
#pragma unroll 4
        for (int ks = 0; ks < nks; ++ks) {
            bf16x8 af[2], bf[4];
#pragma unroll
            for (int i = 0; i < 2; ++i) af[i] = *(const bf16x8*)(ap + (size_t)i * 16 * K + ks * 32);
#pragma unroll
            for (int j = 0; j < 4; ++j) bf[j] = *(const bf16x8*)(bp + (size_t)j * 16 * K + ks * 32);
#pragma unroll
            for (int i = 0; i < 2; ++i)
#pragma unroll
                for (int j = 0; j < 4; ++j) acc[i][j] = mfma16(af[i], bf[j], acc[i][j]);
        }
        float* Pw = P + wid * (32 * 68);
#pragma unroll
        for (int i = 0; i < 2; ++i)
#pragma unroll
            for (int j = 0; j < 4; ++j)
#pragma unroll
                for (int x = 0; x < 4; ++x) Pw[(16 * i + 4 * lq + x) * 68 + 16 * j + lr] = acc[i][j][x];
        __syncthreads();
        {
            const int row = tid >> 4, c4 = (tid & 15) * 4;
            float4 v = *(const float4*)(P + row * 68 + c4);
#pragma unroll
            for (int w = 1; w < 8; ++w) { const float4 u = *(const float4*)(P + w * (32 * 68) + row * 68 + c4); v.x += u.x; v.y += u.y; v.z += u.z; v.w += u.w; }
            const size_t o = (size_t)(row0 + row) * ldc + col0 + c4;
            if (mode == 1) { v.x = fmaxf(v.x, 0.f); v.y = fmaxf(v.y, 0.f); v.z = fmaxf(v.z, 0.f); v.w = fmaxf(v.w, 0.f); v.x *= v.x; v.y *= v.y; v.z *= v.z; v.w *= v.w; }
            if (mode == 2) { const uint2 xv = *(const uint2*)(X + o);
                v.x += DN_ALPHA * __uint_as_float(xv.x << 16); v.y += DN_ALPHA * __uint_as_float(xv.x & 0xffff0000u); v.z += DN_ALPHA * __uint_as_float(xv.y << 16); v.w += DN_ALPHA * __uint_as_float(xv.y & 0xffff0000u); }
            uint2 p; p.x = pk2(v.x, v.y); p.y = pk2(v.z, v.w);
            *(uint2*)(O + o) = p;
        }
        __syncthreads();
    }
}

__device__ __forceinline__ void grid_bar(unsigned* ctl, unsigned round) {
    asm volatile("s_waitcnt vmcnt(0) lgkmcnt(0)" ::: "memory");
    __syncthreads();
    if (threadIdx.x == 0) {
        __builtin_amdgcn_fence(__ATOMIC_RELEASE, "agent");
        asm volatile("s_waitcnt vmcnt(0) lgkmcnt(0)" ::: "memory");
        const unsigned g = blockIdx.x & 7u, per = (gridDim.x - g + 7u) >> 3, ngrp = gridDim.x < 8u ? gridDim.x : 8u;
        const unsigned old = __hip_atomic_fetch_add(ctl + 64u * (1u + g), 1u, __ATOMIC_RELAXED, __HIP_MEMORY_SCOPE_AGENT);
        if (old + 1u == round * per) __hip_atomic_fetch_add(ctl, 1u, __ATOMIC_RELAXED, __HIP_MEMORY_SCOPE_AGENT);
        while (__hip_atomic_load(ctl, __ATOMIC_RELAXED, __HIP_MEMORY_SCOPE_AGENT) < round * ngrp) __builtin_amdgcn_s_sleep(1);
        __builtin_amdgcn_fence(__ATOMIC_ACQUIRE, "agent");
        asm volatile("s_waitcnt vmcnt(0) lgkmcnt(0)" ::: "memory");
    }
    __syncthreads();
}

__global__ void __launch_bounds__(512, 2) mega_fwd(Args a) {
    extern __shared__ __attribute__((aligned(16))) unsigned char lds[];
    cg::grid_group grid = cg::this_grid();
    unsigned nbar = 0;
    bf16_t* XB = (bf16_t*)(a.ws + WS_XB);
    bf16_t* T1 = (bf16_t*)(a.ws + WS_BIG);
    bf16_t* T2 = (bf16_t*)(a.ws + WS_T2);
    bf16_t* Hb = (bf16_t*)(a.ws + WS_BIG);
    bf16_t* Yb = (bf16_t*)(a.ws + WS_Y);
#define RUN(n) ((n) >= a.ph_lo && (n) < a.ph_hi)
#define SYNC(n) do { if ((n) > a.ph_lo) { if (a.ph_hi > 1000) grid.sync(); ++nbar; grid_bar((unsigned*)(a.ws + WS_CTL), nbar); } } while (0)
    if (RUN(0)) {
        weights_phase(a, lds);
        ln_phase<false>(a, lds, a.in[I_XP], a.in[I_XS], a.in[I_LN0G], a.in[I_LN0B], false, nullptr, nullptr, true, 0);
    }
    for (int l = 0; l < 2; ++l) {
        const int p0 = 1 + 8 * l;
        for (int k = 0; k < 8; ++k) {
            const int ph = p0 + k;
            if (!RUN(ph)) continue;
            SYNC(ph);
            for (int rep2 = 0; rep2 < ((REP_K >= 10 && k == REP_K - 10) ? 2 : 1); ++rep2) {
            if (k == 0 || k == 3 || k == 5 || k == 6) {
                pg8::Gemm g; g.M = NPROMPT; EpiAct E; E.act = 0;
                if (k == 0) { g.A = XB; g.Bt = (const bf16_t*)(a.ws + WS_WIN) + (size_t)l * HW * DM; g.N = HW; g.K = DM; E.O = Hb; E.ldc = HW; }
                else if (k == 3) { g.A = Yb; g.Bt = (const bf16_t*)(a.ws + WS_WOUT) + (size_t)l * DM * DM; g.N = DM; g.K = DM; E.O = T1; E.ldc = DM; }
                else if (k == 5) { g.A = XB; g.Bt = (const bf16_t*)(a.ws + WS_WUP) + (size_t)l * DFF * DM; g.N = DFF; g.K = DM; E.O = Hb; E.ldc = DFF; E.act = 1; }
                else { g.A = Hb; g.Bt = (const bf16_t*)(a.ws + WS_WDN) + (size_t)l * DM * DFF; g.N = DM; g.K = DFF; E.O = T2; E.ldc = DM; }
                pg8::StaticOrder S; S.init(g.M, g.N, gridDim.x, opaque_s(blockIdx.x));
#ifndef NO_GEMM
                pg8::gemm_phase<EpiAct, pg8::StaticOrder, false>((PG8_LAS unsigned char*)lds, g, S, E, nullptr);
#endif
                small_gemm_phase(lds, g.A, g.Bt, g.N, g.K, E.O, E.ldc, E.act, nullptr);
            } else if (k == 1) {
#ifndef NO_PREP
                for (int rep = 0; rep < (REP_K == 1 ? 2 : 1); ++rep) prep_phase(a, lds, l);
#endif
            } else if (k == 2) {
#ifndef NO_SCANP
                for (int rep = 0; rep < (REP_K == 2 ? 2 : 1); ++rep) scan_phase(a, lds, l);
#endif
            } else if (k == 4) {
                ln_phase<true>(a, lds, T1, T1 + (size_t)NPROMPT * DM, a.in[I_LN1G] + l * DM, a.in[I_LN1B] + l * DM, false, nullptr, nullptr, false, 0, true);
            } else {
                ln_phase<true>(a, lds, T2, T2 + (size_t)NPROMPT * DM, a.in[I_LN2G] + l * DM, a.in[I_LN2B] + l * DM, opaque_s(l) == 1, a.out, a.out + O_YS, opaque_s(l) == 0, 1, true);
            }
            }
        }
    }
#undef RUN
#undef SYNC
}

extern "C" void kernel_launch(void* const* d_in, const int* in_sizes, int n_in, void* d_out, int out_size, void* d_ws, size_t ws_size, hipStream_t stream) {
    static int grid = 0;
    if (grid == 0) {
        if (n_in != 22 || ws_size < WS_END2) { fprintf(stderr, "kernel_launch: unexpected n_in %d / ws %zu\n", n_in, ws_size); grid = -1; return; }
        int dev = 0, cus = 0, per_cu = 0;
        (void)hipGetDevice(&dev);
        (void)hipDeviceGetAttribute(&cus, hipDeviceAttributeMultiprocessorCount, dev);
        if (hipFuncSetAttribute((const void*)mega_fwd, hipFuncAttributeMaxDynamicSharedMemorySize, LDS_BYTES) != hipSuccess) { fprintf(stderr, "kernel_launch: hipFuncSetAttribute failed\n"); grid = -1; return; }
        if (hipOccupancyMaxActiveBlocksPerMultiprocessor(&per_cu, (const void*)mega_fwd, 512, LDS_BYTES) != hipSuccess || per_cu < 1) { fprintf(stderr, "kernel_launch: occupancy query says %d\n", per_cu); per_cu = 1; }
        (void)hipGetLastError();
        grid = cus * per_cu;
        fprintf(stderr, "kernel_launch: grid %d (cus %d x %d)\n", grid, cus, per_cu);
    }
    if (grid < 0) return;
    (void)hipMemsetAsync((unsigned char*)d_ws + WS_CTL, 0, 4096, stream);
    Args a{};
    for (int i = 0; i < 22; ++i) a.in[i] = (const float*)d_in[i];
    a.out = (float*)d_out; a.ws = (unsigned char*)d_ws;
#if MK_MULTI
    for (int ph = 0; ph < NPHASE; ++ph) { a.ph_lo = ph; a.ph_hi = ph + 1; hipLaunchKernelGGL(mega_fwd, dim3(grid), dim3(512), LDS_BYTES, stream, a); }
#else
    a.ph_lo = 0; a.ph_hi = NPHASE;
    void* args[] = {&a};
    hipError_t e = hipLaunchCooperativeKernel((const void*)mega_fwd, dim3(grid), dim3(512), args, LDS_BYTES, stream);
    if (e != hipSuccess) fprintf(stderr, "kernel_launch: cooperative launch failed: %s (grid %d)\n", hipGetErrorString(e), grid);
#endif
}
```

```cpp
#include <hip/hip_runtime.h>
#include <hip/hip_cooperative_groups.h>
#include <cstdio>
#include <cstdint>
namespace cg = cooperative_groups;
#ifndef MK_MULTI
#define MK_MULTI 0
#endif
#ifndef REP_K
#define REP_K -1
#endif
#ifndef OLD_INV
#define OLD_INV 1
#endif
#ifndef BIS_GW
#define BIS_GW 0
#endif
#ifndef BIS_KDT
#define BIS_KDT 0
#endif
#ifndef BIS_S1
#define BIS_S1 1
#endif
#ifndef BIS_S2
#define BIS_S2 1
#endif
#ifndef BIS_RAW
#define BIS_RAW 1
#endif
#ifndef BIS_A
#define BIS_A 1
#endif
#ifndef BIS_B
#define BIS_B 1
#endif
namespace pg8 {
#define PG8_LAS __attribute__((address_space(3)))
typedef unsigned short bf16_t;
typedef short bf16x8 __attribute__((ext_vector_type(8)));
typedef float f32x4 __attribute__((ext_vector_type(4)));
typedef unsigned u32x4 __attribute__((ext_vector_type(4)));
constexpr int BM = 256, BK = 64, HALF = 128, HTB = HALF * BK * 2  , STAGE_BYTES = 8 * HTB, NXCD = 8, WGM = 8;

__host__ __device__ __forceinline__ int lds_byte(int r, int c) { const int st = (r >> 4) * 2 + (c >> 5), rr = r & 15, cc = c & 31, ob = rr * 64 + cc * 2; return st * 1024 + (ob ^ (((ob >> 9) & 1) << 5)); }
__host__ __device__ __forceinline__ void stage_rc(int b, int& R, int& C) { const int st = b / 1024, sb = b % 1024, swz = sb ^ (((sb >> 9) & 1) << 5); R = (st >> 1) * 16 + swz / 64; C = (st & 1) * 32 + (swz % 64) / 2; }
__host__ __device__ __forceinline__ int perm32(int rho) { const int n = rho >> 4, i = rho & 15; return 8 * (i >> 2) + 4 * n + (i & 3); }

struct Unit { int pm, pn; };
struct Gemm { const bf16_t* A; const bf16_t* Bt; int M, N, K; };

struct StaticOrder {
    int nM, nN, nwg, G, c;
    __host__ __device__ void init(int M, int N, int G_, int c_) { nM = M / BM; nN = N / BM; nwg = nM * nN; G = G_; c = c_; }
    __host__ __device__ bool next(int i, Unit& u) const {
        const long L = (long)i * G + c; if (L >= nwg) return false;
        int wgid = (int)L; { const int q = nwg / NXCD, r = nwg % NXCD, xcd = wgid % NXCD, off = wgid / NXCD; wgid = (xcd < r ? xcd * (q + 1) : r * (q + 1) + (xcd - r) * q) + off; }
        const int nig = WGM * nN, gid = wgid / nig, fm = gid * WGM, gsz = (nM - fm) < WGM ? (nM - fm) : WGM;
        u.pm = fm + ((wgid % nig) % gsz); u.pn = (wgid % nig) / gsz; return true;
    }
    __device__ __forceinline__ void a_ready(const Unit&) const {}
    __device__ __forceinline__ void done(const Unit&) const {}
};
typedef __bf16 bf16x2_cv __attribute__((ext_vector_type(2))); typedef float f32x2_cv __attribute__((ext_vector_type(2)));
__device__ __forceinline__ unsigned cvt_pk_bf16(float lo, float hi) { const f32x2_cv v = {lo, hi}; return __builtin_bit_cast(unsigned, __builtin_convertvector(v, bf16x2_cv)); }
template <class Epi, class Sched, bool STAMP = false>
__device__ __forceinline__ void gemm_phase(PG8_LAS unsigned char* lds, const Gemm g, const Sched& S, const Epi& E, unsigned long long* stamps) {
    int tid_ = threadIdx.x; asm volatile("" : "+v"(tid_)); const int tid = tid_, wid = __builtin_amdgcn_readfirstlane(tid >> 6), lane = tid & 63, wr = wid >> 2, wc = wid & 3, fr = lane & 15, fq = lane >> 4;
    const int K = g.K, nt = K / BK;
    int ts_lo = 0, ts_hi = 0, nts = 0; const unsigned long long rt_entry = STAMP ? (unsigned long long)wall_clock64() : 0ull;
#define PG8_STAMP() do { if (STAMP && wid == 0 && nts < 64) { const unsigned long long _c = (unsigned long long)clock64(); \
        ts_lo = (lane == nts) ? (int)(unsigned)_c : ts_lo; ts_hi = (lane == nts) ? (int)(unsigned)(_c >> 32) : ts_hi; ++nts; } } while (0)
    PG8_STAMP();
    unsigned voffA[2], voffB[2];
#pragma unroll
    for (int i = 0; i < 2; ++i) { int R, C; stage_rc(tid * 16 + i * 8192, R, C); const int Rb = Epi::PERM ? ((R & ~31) + perm32(R & 31)) : R;
        voffA[i] = (unsigned)(R * K + C) * 2u; voffB[i] = (unsigned)(Rb * K + C) * 2u; }
    const size_t kstep = (size_t)(BK * 2);
    const size_t hstep = (size_t)HALF * K * 2;
    const size_t tstep = 2 * hstep;
    const unsigned ldsw = (unsigned)wid * 1024u;
    const int aoff = lds_byte(wr * 64 + fr, fq * 8), boff = lds_byte(wc * 32 + fr, fq * 8);
#define PG8_SA(b, h) (((b) * 2 + (h)) * HTB)
#define PG8_SB(b, h) ((4 + (b) * 2 + (h)) * HTB)
#define PG8_STAGE(bufoff, gbase, voff) do { _Pragma("unroll") for (int _i = 0; _i < 2; ++_i) \
        __builtin_amdgcn_global_load_lds((const unsigned*)((const char*)(gbase) + (voff)[_i]), (PG8_LAS unsigned*)(lds + (bufoff) + ldsw + _i * 8192), 16, 0, 0); } while (0)
#define PG8_LDA(dst, b, h) do { _Pragma("unroll") for (int m = 0; m < 4; ++m) _Pragma("unroll") for (int k = 0; k < 2; ++k) dst[m][k] = *(const PG8_LAS bf16x8*)(lds + PG8_SA(b, h) + aoff + m * 2048 + k * 1024); } while (0)
#define PG8_LDB(dst, b, h) do { _Pragma("unroll") for (int n = 0; n < 2; ++n) _Pragma("unroll") for (int k = 0; k < 2; ++k) dst[n][k] = *(const PG8_LAS bf16x8*)(lds + PG8_SB(b, h) + boff + n * 2048 + k * 1024); } while (0)
#define PG8_MMA(ai, bj, At, Bt) do { __builtin_amdgcn_s_setprio(1); _Pragma("unroll") for (int m = 0; m < 4; ++m) _Pragma("unroll") for (int n = 0; n < 2; ++n) _Pragma("unroll") for (int k = 0; k < 2; ++k) \
        acc[ai][bj][m][n] = __builtin_amdgcn_mfma_f32_16x16x32_bf16(Bt[n][k], At[m][k], acc[ai][bj][m][n], 0, 0, 0); __builtin_amdgcn_s_setprio(0); } while (0)
#define PG8_WAIT_V(n) asm volatile("s_waitcnt vmcnt(" #n ")" ::: "memory")
#define PG8_WAIT_L(n) asm volatile("s_waitcnt lgkmcnt(" #n ")" ::: "memory")
#define PG8_BAR __builtin_amdgcn_s_barrier()
#define PG8_SCHED __builtin_amdgcn_sched_barrier(0)
    Unit cur, nxt; int ui = 0;
    if (!S.next(0, cur)) return;
    f32x4 acc[2][2][4][2];
#pragma unroll
    for (int a = 0; a < 2; ++a)
#pragma unroll
        for (int b = 0; b < 2; ++b)
#pragma unroll
            for (int m = 0; m < 4; ++m)
#pragma unroll
                for (int n = 0; n < 2; ++n) acc[a][b][m][n] = (f32x4){0.f, 0.f, 0.f, 0.f};
    bf16x8 At[4][2], B0[2][2], B1[2][2];
    const char* cA = (const char*)g.A + (size_t)cur.pm * tstep; const char* cB = (const char*)g.Bt + (size_t)cur.pn * tstep;
    S.a_ready(cur);
    PG8_STAGE(PG8_SB(0, 0), cB, voffB); PG8_STAGE(PG8_SA(0, 0), cA, voffA); PG8_STAGE(PG8_SB(0, 1), cB + hstep, voffB); PG8_STAGE(PG8_SA(0, 1), cA + hstep, voffA);
    if (wr == 1) PG8_BAR;
    PG8_WAIT_V(4); PG8_BAR;
    PG8_STAGE(PG8_SB(1, 0), cB + kstep, voffB); PG8_STAGE(PG8_SA(1, 0), cA + kstep, voffA); PG8_STAGE(PG8_SB(1, 1), cB + hstep + kstep, voffB);
    PG8_WAIT_V(6); PG8_BAR;
    PG8_STAMP();
    for (;;) {
        const bool has_next = S.next(ui + 1, nxt);
        const char* nA = has_next ? (const char*)g.A + (size_t)nxt.pm * tstep : cA; const char* nB = has_next ? (const char*)g.Bt + (size_t)nxt.pn * tstep : cB;
        for (int t = 0; t < nt; t += 2) {
            const bool last = (t == nt - 2);
            const char* a1 = cA + (size_t)(t + 1) * kstep;
            const char* a2 = last ? nA : cA + (size_t)(t + 2) * kstep; const char* b2 = last ? nB : cB + (size_t)(t + 2) * kstep;
            const char* a3 = a2 + kstep; const char* b3 = b2 + kstep;
            if (last && has_next) S.a_ready(nxt);
            PG8_LDB(B0, 0, 0); PG8_SCHED; PG8_LDA(At, 0, 0); PG8_STAGE(PG8_SA(1, 1), a1 + hstep, voffA);
            PG8_WAIT_L(8); PG8_BAR; PG8_WAIT_L(0); PG8_MMA(0, 0, At, B0); PG8_BAR; PG8_SCHED;
            PG8_LDB(B1, 0, 1); PG8_STAGE(PG8_SB(0, 0), b2, voffB);
            PG8_BAR; PG8_WAIT_L(0); PG8_MMA(0, 1, At, B1); PG8_BAR;
            PG8_LDA(At, 0, 1); PG8_STAGE(PG8_SA(0, 0), a2, voffA);
            PG8_BAR; PG8_WAIT_L(0); PG8_MMA(1, 0, At, B0); PG8_BAR; PG8_SCHED;
            PG8_STAGE(PG8_SB(0, 1), b2 + hstep, voffB);
            PG8_WAIT_V(6); PG8_BAR; PG8_MMA(1, 1, At, B1); PG8_BAR;
            PG8_LDB(B0, 1, 0); PG8_SCHED; PG8_LDA(At, 1, 0); PG8_STAGE(PG8_SA(0, 1), a2 + hstep, voffA);
            PG8_WAIT_L(8); PG8_BAR; PG8_WAIT_L(0); PG8_MMA(0, 0, At, B0); PG8_BAR; PG8_SCHED;
            PG8_LDB(B1, 1, 1); PG8_STAGE(PG8_SB(1, 0), b3, voffB);
            PG8_BAR; PG8_WAIT_L(0); PG8_MMA(0, 1, At, B1); PG8_BAR;
            PG8_LDA(At, 1, 1); PG8_STAGE(PG8_SA(1, 0), a3, voffA);
            PG8_BAR; PG8_WAIT_L(0); PG8_MMA(1, 0, At, B0); PG8_BAR; PG8_SCHED;
            PG8_STAGE(PG8_SB(1, 1), b3 + hstep, voffB);
            PG8_WAIT_V(6); PG8_BAR; PG8_MMA(1, 1, At, B1); PG8_BAR;
        }
        PG8_STAMP();
        if constexpr (!Epi::AFTER_DRAIN) { E(acc, cur, wr, wc, fr, fq); S.done(cur); }
        PG8_STAMP();
        if (!has_next) break;
#pragma unroll
        for (int a = 0; a < 2; ++a)
#pragma unroll
            for (int b = 0; b < 2; ++b)
#pragma unroll
                for (int m = 0; m < 4; ++m)
#pragma unroll
                    for (int n = 0; n < 2; ++n) acc[a][b][m][n] = (f32x4){0.f, 0.f, 0.f, 0.f};
        cur = nxt; cA = nA; cB = nB; ++ui;
    }
    PG8_WAIT_V(0);
    if (wr == 0) PG8_BAR;
    PG8_BAR;
    if constexpr (Epi::AFTER_DRAIN) { E.fused(acc, cur, wr, wc, fr, fq, lds, wid, lane); S.done(cur); }
    PG8_STAMP();
    if (STAMP && wid == 0) { stamps[lane] = lane < nts ? (((unsigned long long)(unsigned)ts_hi << 32) | (unsigned)ts_lo) : 0ull;
        if (lane == 62) stamps[62] = rt_entry; if (lane == 63) stamps[63] = (unsigned long long)wall_clock64(); }
#undef PG8_STAMP
#undef PG8_SA
#undef PG8_SB
#undef PG8_STAGE
#undef PG8_LDA
#undef PG8_LDB
#undef PG8_MMA
#undef PG8_WAIT_V
#undef PG8_WAIT_L
#undef PG8_BAR
#undef PG8_SCHED
}
}

using pg8::bf16_t; using pg8::bf16x8; using pg8::f32x4; using pg8::u32x4;

constexpr int DM = 1024, NTOK = 66048, NPROMPT = 65536, INW = 3080, HW = 3072, DFF = 4096;
constexpr int NITEM = 4128;
constexpr float DN_ALPHA = 1.4142135623730951f;
constexpr size_t WS_WIN = 0, WS_WOUT = 12582912, WS_WUP = 16777216, WS_WDN = 33554432, WS_XB = 50331648, WS_LOG = 185597952,
                 WS_ATT = 187711488, WS_GL = 221528064, WS_BIG = 221593600, WS_Y = WS_BIG + 405798912, WS_END = WS_BIG + 541065216, WS_CTL = WS_END, WS_T2 = WS_END + 65536, WS_END2 = WS_T2 + 135266304;
constexpr size_t O_YS = 67108864, O_CONVP = 67633152, O_DELTAP = 67780608, O_CONVS = 69877760, O_DELTAS = 69951488, O_SMLPV = 71000064;
constexpr int LDS_BYTES = 150016;
constexpr int NPHASE = 17;

struct Args { const float* in[22]; float* out; unsigned char* ws; int ph_lo, ph_hi; };
enum { I_XP = 0, I_XS, I_CCONV, I_SDELTA, I_LN0G, I_LN0B, I_WIN, I_CONVW, I_ALOG, I_DTB, I_GNG, I_SLNG, I_SLNB, I_WS, I_BS, I_WOUT, I_LN1G, I_LN1B, I_WUP, I_WDN, I_LN2G, I_LN2B };

__device__ __forceinline__ int opaque_v(int x) { asm volatile("" : "+v"(x)); return x; }
__device__ __forceinline__ int opaque_s(int x) { asm volatile("" : "+s"(x)); return x; }
__device__ __forceinline__ float bf2f(unsigned short b) { return __uint_as_float((unsigned)b << 16); }
__device__ __forceinline__ unsigned pk2(float lo, float hi) { return pg8::cvt_pk_bf16(lo, hi); }
__device__ __forceinline__ unsigned short f2bf(float f) { return (unsigned short)(pk2(f, 0.f) & 0xffffu); }
__device__ __forceinline__ void unpack8(const uint4 v, float* o) {
    o[0] = __uint_as_float(v.x << 16); o[1] = __uint_as_float(v.x & 0xffff0000u); o[2] = __uint_as_float(v.y << 16); o[3] = __uint_as_float(v.y & 0xffff0000u);
    o[4] = __uint_as_float(v.z << 16); o[5] = __uint_as_float(v.z & 0xffff0000u); o[6] = __uint_as_float(v.w << 16); o[7] = __uint_as_float(v.w & 0xffff0000u);
}
__device__ __forceinline__ uint4 pack8(const float* x) { uint4 r; r.x = pk2(x[0], x[1]); r.y = pk2(x[2], x[3]); r.z = pk2(x[4], x[5]); r.w = pk2(x[6], x[7]); return r; }
__device__ __forceinline__ uint2 pack4(const f32x4 v) { uint2 r; r.x = pk2(v[0], v[1]); r.y = pk2(v[2], v[3]); return r; }
template <int CTRL> __device__ __forceinline__ float dpp_mov(float v) { return __builtin_bit_cast(float, __builtin_amdgcn_update_dpp(0, __builtin_bit_cast(int, v), CTRL, 0xf, 0xf, true)); }
__device__ __forceinline__ float sum4(float v) { v += dpp_mov<0xB1>(v); v += dpp_mov<0x4E>(v); return v; }
__device__ __forceinline__ float sum8(float v) { v = sum4(v); v += dpp_mov<0x141>(v); return v; }
__device__ __forceinline__ float sum16(float v) { v = sum8(v); v += dpp_mov<0x140>(v); return v; }
__device__ __forceinline__ float wave_sum(float v) { v = sum16(v); v += __shfl_xor(v, 16); v += __shfl_xor(v, 32); return v; }
__device__ __forceinline__ float gelu_f(float v) {
    const float t = __builtin_amdgcn_rcpf(fabsf(v) * 0.2316418882f + 1.0f);
    float q = t * 0.5307027145f + (-0.7265760135f); q = q * t + 0.7107068705f; q = q * t + (-0.142248368f); q = q * t + 0.127414796f; q = q * t;
    const float e = __builtin_amdgcn_exp2f((v * v) * (-0.72134752044f));
    const float m = v * (q * e);
    return v < 0.f ? m : v - m;
}
__device__ __forceinline__ float silu_f(float x) { return x * __builtin_amdgcn_rcpf(1.0f + __builtin_amdgcn_exp2f(x * (-1.4426950408889634f))); }
__device__ __forceinline__ f32x4 mfma16(const bf16x8 a, const bf16x8 b, const f32x4 c) { return __builtin_amdgcn_mfma_f32_16x16x32_bf16(a, b, c, 0, 0, 0); }

struct EpiAct {
    static constexpr bool PERM = true, AFTER_DRAIN = false;
    bf16_t* O; int ldc; int act;
    __device__ __forceinline__ void operator()(const f32x4 (&acc)[2][2][4][2], const pg8::Unit& u, int wr, int wc, int fr, int fq) const {
        const int row0 = u.pm * 256 + wr * 64 + fr, col0 = u.pn * 256 + wc * 32 + 8 * fq;
#pragma unroll
        for (int ai = 0; ai < 2; ++ai)
#pragma unroll
            for (int m = 0; m < 4; ++m) { bf16_t* rowp = O + (size_t)(row0 + ai * 128 + m * 16) * ldc + col0;
#pragma unroll
                for (int bj = 0; bj < 2; ++bj) { f32x4 v0 = acc[ai][bj][m][0], v1 = acc[ai][bj][m][1];
                    if (act) {
#pragma unroll
                        for (int j = 0; j < 4; ++j) { float p = fmaxf(v0[j], 0.f), q = fmaxf(v1[j], 0.f); v0[j] = p * p; v1[j] = q * q; } }
                    u32x4 w; w.x = pk2(v0[0], v0[1]); w.y = pk2(v0[2], v0[3]); w.z = pk2(v1[0], v1[1]); w.w = pk2(v1[2], v1[3]);
                    *(u32x4*)(rowp + bj * 128) = w; } }
    }
};
struct EpiRes {
    static constexpr bool PERM = true, AFTER_DRAIN = false;
    bf16_t* O; const bf16_t* X;
    __device__ __forceinline__ void operator()(const f32x4 (&acc)[2][2][4][2], const pg8::Unit& u, int wr, int wc, int fr, int fq) const {
        const int row0 = u.pm * 256 + wr * 64 + fr, col0 = u.pn * 256 + wc * 32 + 8 * fq;
#pragma unroll
        for (int ai = 0; ai < 2; ++ai)
#pragma unroll
            for (int m = 0; m < 4; ++m) { const size_t ro = (size_t)(row0 + ai * 128 + m * 16) * DM + col0;
#pragma unroll
                for (int bj = 0; bj < 2; ++bj) { const size_t o = ro + bj * 128; const uint4 xv = *(const uint4*)(X + o);
                    u32x4 w;
                    w.x = pk2(acc[ai][bj][m][0][0] + DN_ALPHA * __uint_as_float(xv.x << 16), acc[ai][bj][m][0][1] + DN_ALPHA * __uint_as_float(xv.x & 0xffff0000u));
                    w.y = pk2(acc[ai][bj][m][0][2] + DN_ALPHA * __uint_as_float(xv.y << 16), acc[ai][bj][m][0][3] + DN_ALPHA * __uint_as_float(xv.y & 0xffff0000u));
                    w.z = pk2(acc[ai][bj][m][1][0] + DN_ALPHA * __uint_as_float(xv.z << 16), acc[ai][bj][m][1][1] + DN_ALPHA * __uint_as_float(xv.z & 0xffff0000u));
                    w.w = pk2(acc[ai][bj][m][1][2] + DN_ALPHA * __uint_as_float(xv.w << 16), acc[ai][bj][m][1][3] + DN_ALPHA * __uint_as_float(xv.w & 0xffff0000u));
                    *(u32x4*)(O + o) = w; __builtin_amdgcn_sched_barrier(0); } }
    }
};

__device__ __forceinline__ void transpose_tile(const float* __restrict__ src, int ld_src, bf16_t* __restrict__ dst, int ld_dst, int k0, int n0s, int n0d, float* tile) {
    const int tidt = opaque_v(threadIdx.x);
    {
        const int c4 = tidt & 15;
#pragma unroll
        for (int i = 0; i < 2; ++i) { const int k = (tidt >> 4) + 32 * i; const float4 v = *(const float4*)(src + (size_t)(k0 + k) * ld_src + n0s + c4 * 4);
            tile[k * 65 + c4 * 4] = v.x; tile[k * 65 + c4 * 4 + 1] = v.y; tile[k * 65 + c4 * 4 + 2] = v.z; tile[k * 65 + c4 * 4 + 3] = v.w; }
    }
    __syncthreads();
    {
        const int n = tidt >> 3, kseg = tidt & 7;
        float t8[8];
#pragma unroll
        for (int i = 0; i < 8; ++i) t8[i] = tile[(kseg * 8 + i) * 65 + n];
        *(uint4*)(dst + (size_t)(n0d + n) * ld_dst + k0 + kseg * 8) = pack8(t8);
    }
    __syncthreads();
}
__device__ __forceinline__ void weights_phase(const Args& a, unsigned char* lds) {
    float* tile = (float*)lds;
    for (int t = opaque_s(blockIdx.x); t < 6144; t += gridDim.x) {
        if (t < 1536) { const int l = t / 768, r = t % 768, kt = r / 48, nt = r % 48; const int n0d = nt * 64, n0s = n0d < 2048 ? n0d : n0d + 8;
            transpose_tile(a.in[I_WIN] + (size_t)l * DM * INW, INW, (bf16_t*)(a.ws + WS_WIN) + (size_t)l * HW * DM, DM, kt * 64, n0s, n0d, tile); }
        else if (t < 2048) { const int q = t - 1536, l = q / 256, r = q % 256, kt = r / 16, nt = r % 16;
            transpose_tile(a.in[I_WOUT] + (size_t)l * DM * DM, DM, (bf16_t*)(a.ws + WS_WOUT) + (size_t)l * DM * DM, DM, kt * 64, nt * 64, nt * 64, tile); }
        else if (t < 4096) { const int q = t - 2048, l = q / 1024, r = q % 1024, kt = r / 64, nt = r % 64;
            transpose_tile(a.in[I_WUP] + (size_t)l * DM * DFF, DFF, (bf16_t*)(a.ws + WS_WUP) + (size_t)l * DFF * DM, DM, kt * 64, nt * 64, nt * 64, tile); }
        else { const int q = t - 4096, l = q / 1024, r = q % 1024, kt = r / 16, nt = r % 16;
            transpose_tile(a.in[I_WDN] + (size_t)l * DFF * DM, DM, (bf16_t*)(a.ws + WS_WDN) + (size_t)l * DM * DFF, DFF, kt * 64, nt * 64, nt * 64, tile); }
    }
}

template <bool SRC_BF16>
__device__ __forceinline__ void ln_phase(const Args& a, unsigned char* lds, const void* srcP, const void* srcS, const float* __restrict__ g, const float* __restrict__ b,
                                         bool f32out, float* dstP, float* dstS, bool logits, int lnext, bool resid = false) {
    const int tid = opaque_v(threadIdx.x), lane = tid & 63, wid = tid >> 6;
    float* wl = (float*)lds;
    if (logits) {
        const float* w = a.in[I_WIN] + (size_t)lnext * DM * INW;
        for (int i = tid; i < 8192; i += 512) { const int k = i >> 3, j = i & 7; wl[j * 1024 + k] = w[(size_t)k * INW + 2048 + j]; }
        __syncthreads();
    }
    bf16_t* xb = (bf16_t*)(a.ws + WS_XB); float* LOG = (float*)(a.ws + WS_LOG);
    float gv[16], bv[16];
#pragma unroll
    for (int i = 0; i < 2; ++i)
#pragma unroll
        for (int e = 0; e < 2; ++e) { const float4 t = *(const float4*)(g + i * 512 + lane * 8 + 4 * e), u = *(const float4*)(b + i * 512 + lane * 8 + 4 * e);
            gv[i * 8 + e * 4] = t.x; gv[i * 8 + e * 4 + 1] = t.y; gv[i * 8 + e * 4 + 2] = t.z; gv[i * 8 + e * 4 + 3] = t.w;
            bv[i * 8 + e * 4] = u.x; bv[i * 8 + e * 4 + 1] = u.y; bv[i * 8 + e * 4 + 2] = u.z; bv[i * 8 + e * 4 + 3] = u.w; }
    uint4 pr0 = make_uint4(0u, 0u, 0u, 0u), pr1 = pr0, px0 = pr0, px1 = pr0;
#define LN_PREFETCH(ROW) do { const size_t ro_ = (ROW) < NPROMPT ? (size_t)(ROW) * DM : (size_t)((ROW) - NPROMPT) * DM; \
        const bf16_t* src_ = ((ROW) < NPROMPT ? (const bf16_t*)srcP : (const bf16_t*)srcS) + ro_; \
        pr0 = *(const uint4*)(src_ + lane * 8); pr1 = *(const uint4*)(src_ + 512 + lane * 8); \
        if (resid) { px0 = *(const uint4*)(xb + (size_t)(ROW) * DM + lane * 8); px1 = *(const uint4*)(xb + (size_t)(ROW) * DM + 512 + lane * 8); } } while (0)
    if (SRC_BF16) { const int row_first = opaque_s(blockIdx.x) * 8 + wid; if (row_first < NTOK) LN_PREFETCH(row_first); }
    for (int row = opaque_s(blockIdx.x) * 8 + wid; row < NTOK; row += gridDim.x * 8) {
        const size_t ro = row < NPROMPT ? (size_t)row * DM : (size_t)(row - NPROMPT) * DM;
        float v[16];
        if (SRC_BF16) {
            const uint4 r0 = pr0, r1 = pr1, x0 = px0, x1 = px1;
            { const int nrow = row + (int)gridDim.x * 8; if (nrow < NTOK) LN_PREFETCH(nrow); }
            unpack8(r0, v); unpack8(r1, v + 8);
            if (resid) {
                float xv[16]; unpack8(x0, xv); unpack8(x1, xv + 8);
#pragma unroll
                for (int i = 0; i < 16; ++i) v[i] += DN_ALPHA * xv[i];
            }
        } else {
            const float* src = (row < NPROMPT ? (const float*)srcP : (const float*)srcS) + ro;
#pragma unroll
            for (int i = 0; i < 2; ++i)
#pragma unroll
                for (int e = 0; e < 2; ++e) { const float4 t = *(const float4*)(src + i * 512 + lane * 8 + 4 * e); v[i * 8 + e * 4] = t.x; v[i * 8 + e * 4 + 1] = t.y; v[i * 8 + e * 4 + 2] = t.z; v[i * 8 + e * 4 + 3] = t.w; }
        }
        float s = 0.f;
#pragma unroll
        for (int i = 0; i < 16; ++i) s += v[i];
        const float mean = wave_sum(s) * (1.0f / 1024.0f);
        float q = 0.f;
#pragma unroll
        for (int i = 0; i < 16; ++i) { v[i] -= mean; q += v[i] * v[i]; }
        const float rstd = rsqrtf(wave_sum(q) * (1.0f / 1024.0f) + 1e-5f);
#pragma unroll
        for (int i = 0; i < 16; ++i) v[i] = v[i] * rstd * gv[i] + bv[i];
        if (!f32out) { *(uint4*)(xb + (size_t)row * DM + lane * 8) = pack8(v); *(uint4*)(xb + (size_t)row * DM + 512 + lane * 8) = pack8(v + 8); }
        if (f32out) { float* dst = (row < NPROMPT ? dstP : dstS) + ro;
#pragma unroll
            for (int i = 0; i < 2; ++i)
#pragma unroll
                for (int e = 0; e < 2; ++e) *(float4*)(dst + i * 512 + lane * 8 + 4 * e) = make_float4(v[i * 8 + e * 4], v[i * 8 + e * 4 + 1], v[i * 8 + e * 4 + 2], v[i * 8 + e * 4 + 3]); }
        if (logits) {
            float p[8];
#pragma unroll
            for (int j = 0; j < 8; ++j) { float q8 = 0.f;
#pragma unroll
                for (int i = 0; i < 2; ++i)
#pragma unroll
                    for (int e = 0; e < 2; ++e) { const float4 w = *(const float4*)(wl + j * 1024 + i * 512 + lane * 8 + 4 * e);
                        q8 += (v[i * 8 + e * 4] * w.x + v[i * 8 + e * 4 + 1] * w.y) + (v[i * 8 + e * 4 + 2] * w.z + v[i * 8 + e * 4 + 3] * w.w); }
                p[j] = q8; }
            const bool b0 = (lane & 1) != 0, b1 = (lane & 2) != 0, b2 = (lane & 4) != 0;
            float k1[4], k2[2], k3;
#pragma unroll
            for (int i = 0; i < 4; ++i) { const float send = b0 ? p[i] : p[4 + i], keep = b0 ? p[4 + i] : p[i]; k1[i] = keep + __shfl_xor(send, 1); }
#pragma unroll
            for (int i = 0; i < 2; ++i) { const float send = b1 ? k1[i] : k1[2 + i], keep = b1 ? k1[2 + i] : k1[i]; k2[i] = keep + __shfl_xor(send, 2); }
            { const float send = b2 ? k2[0] : k2[1], keep = b2 ? k2[1] : k2[0]; k3 = keep + __shfl_xor(send, 4); }
            k3 += __shfl_xor(k3, 8); k3 += __shfl_xor(k3, 16); k3 += __shfl_xor(k3, 32);
            if (lane < 8) LOG[(size_t)row * 8 + ((lane & 1) * 4 + ((lane >> 1) & 1) * 2 + ((lane >> 2) & 1))] = k3;
        }
    }
#undef LN_PREFETCH
    __syncthreads();
}

constexpr int PL_TM = 17408, PL_XM = 34816, PL_G = 39424, PL_CW = 40192, PL_KS = 64768, PL_QS = 82176, PL_VB = 99584, PL_KG = 116992;
#define PREP_PREFETCH(ITEM) do { const int t0_ = ((ITEM) >> 2) * 64, h_ = (ITEM) & 3; \
        _Pragma("unroll") for (int w_ = 0; w_ < 3; ++w_) _Pragma("unroll") for (int j_ = 0; j_ < 4; ++j_) { \
            int row_ = t0_ + r + j_ - 3; row_ = row_ < 0 ? 0 : row_; \
            const uint4* p_ = (const uint4*)(H + (size_t)row_ * HW + w_ * 512 + h_ * 128 + cgi * 16); raw[w_][j_][0] = p_[0]; raw[w_][j_][1] = p_[1]; } } while (0)
__device__ __forceinline__ void gdn_prep_item(const Args& a, unsigned char* lds, int l, int item, int nitem, uint4 (&raw)[3][4][2], float& pbl, float& pal) {
    const int tid = opaque_v(threadIdx.x), lane = tid & 63, wid = tid >> 6, lr = lane & 15, lq = lane >> 4;
    const int c64 = item >> 2, h = item & 3, tok0 = c64 * 64;
    const bool sample = c64 >= 1024;
    const int mode = sample ? 2 : ((c64 & 63) == 0 ? 0 : 1);
    const bf16_t* H = (const bf16_t*)(a.ws + WS_BIG);
    const float* LOG = (const float*)(a.ws + WS_LOG);
    float* Am = (float*)(lds); float* Tm = (float*)(lds + PL_TM); float* Xm = (float*)(lds + PL_XM);
    float* gcs = (float*)(lds + PL_G); float* bts = gcs + 64; float* egs = gcs + 128; const float* cws = (const float*)(lds + PL_CW);
    bf16_t* Ks = (bf16_t*)(lds + PL_KS); bf16_t* Qs = (bf16_t*)(lds + PL_QS); bf16_t* VBs = (bf16_t*)(lds + PL_VB); bf16_t* KGs = (bf16_t*)(lds + PL_KG);
    unsigned char* ib = (unsigned char*)a.out + (size_t)item * 65536;
    bf16_t* NW = (bf16_t*)ib; bf16_t* UF = (bf16_t*)(ib + 16384); bf16_t* QD = (bf16_t*)(ib + 32768); bf16_t* KDT = (bf16_t*)(ib + 49152);
    bf16_t* ATT = (bf16_t*)(a.ws + WS_ATT) + (size_t)item * 4096;
    const int r = tid >> 3, cgi = tid & 7;
    if (wid == 0) {
        const float bl = pbl, al = pal;
        { const int nt0 = (nitem >> 2) * 64, nh = nitem & 3; const float* lg = LOG + (size_t)(nt0 + lane) * 8; pbl = lg[nh]; pal = lg[4 + nh]; }
        const float A = expf(a.in[I_ALOG][l * 4 + h]); const float x = al + a.in[I_DTB][l * 4 + h];
        const float sp = x > 20.f ? x : log1pf(expf(x));
        float g = -A * sp;
#pragma unroll
        for (int o = 1; o < 64; o <<= 1) { const float t = __shfl_up(g, o); if (lane >= o) g += t; }
        const float gl = __shfl(g, 63);
        gcs[lane] = g; bts[lane] = 1.0f / (1.0f + expf(-bl)); egs[lane] = expf(gl - g);
        if (lane == 63) ((float*)(a.ws + WS_GL))[item] = expf(g);
    }
    for (int i = tid; i < 64 * 68; i += 512) Tm[i] = 0.f;
    __syncthreads();
    {
        const float gc = gcs[r], bt = bts[r];
        const float eg = expf(gc);
        const float* cc = a.in[I_CCONV] + (size_t)(l * 8 + (sample ? c64 - 1024 : 0)) * 3 * 1536;
#pragma unroll
        for (int which = 0; which < 3; ++which) {
            const int col = which * 512 + h * 128 + cgi * 16;
            float acc[16];
#pragma unroll
            for (int i = 0; i < 16; ++i) acc[i] = 0.f;
#pragma unroll
            for (int j = 0; j < 4; ++j) {
                const int rr = r + j - 3;
                float x[16];
                unpack8(raw[which][j][0], x); unpack8(raw[which][j][1], x + 8);
                if (rr < 0 && mode != 1) {
                    if (mode == 2) { const float4* p = (const float4*)(cc + (size_t)(rr + 3) * 1536 + col);
#pragma unroll
                        for (int i = 0; i < 4; ++i) { const float4 t = p[i]; x[4 * i] = t.x; x[4 * i + 1] = t.y; x[4 * i + 2] = t.z; x[4 * i + 3] = t.w; } }
                    else {
#pragma unroll
                        for (int i = 0; i < 16; ++i) x[i] = 0.f; }
                }
                const float4* wp = (const float4*)(cws + j * 1536 + col);
#pragma unroll
                for (int i = 0; i < 4; ++i) { const float4 w = wp[i]; acc[4 * i] += x[4 * i] * w.x; acc[4 * i + 1] += x[4 * i + 1] * w.y; acc[4 * i + 2] += x[4 * i + 2] * w.z; acc[4 * i + 3] += x[4 * i + 3] * w.w; }
            }
#pragma unroll
            for (int i = 0; i < 16; ++i) acc[i] = silu_f(acc[i]);
            if (which < 2) {
                float ss = 0.f;
#pragma unroll
                for (int i = 0; i < 16; ++i) ss += acc[i] * acc[i];
                ss = sum8(ss);
                const float sc = rsqrtf(ss + 1e-6f) * (which == 0 ? 0.08838834764831845f : 1.0f);
#pragma unroll
                for (int i = 0; i < 16; ++i) acc[i] *= sc;
            }
            float t[16];
            if (which == 0) {
                *(uint4*)(Qs + r * 136 + cgi * 16) = pack8(acc); *(uint4*)(Qs + r * 136 + cgi * 16 + 8) = pack8(acc + 8);
#pragma unroll
                for (int i = 0; i < 16; ++i) t[i] = acc[i] * eg;
                *(uint4*)(QD + r * 128 + cgi * 16) = pack8(t); *(uint4*)(QD + r * 128 + cgi * 16 + 8) = pack8(t + 8);
            } else if (which == 1) {
                *(uint4*)(Ks + r * 136 + cgi * 16) = pack8(acc); *(uint4*)(Ks + r * 136 + cgi * 16 + 8) = pack8(acc + 8);
                const float f = bt * eg;
#pragma unroll
                for (int i = 0; i < 16; ++i) t[i] = acc[i] * f;
                *(uint4*)(KGs + r * 136 + cgi * 16) = pack8(t); *(uint4*)(KGs + r * 136 + cgi * 16 + 8) = pack8(t + 8);
            } else {
#pragma unroll
                for (int i = 0; i < 16; ++i) t[i] = acc[i] * bt;
                *(uint4*)(VBs + r * 136 + cgi * 16) = pack8(t); *(uint4*)(VBs + r * 136 + cgi * 16 + 8) = pack8(t + 8);
            }
        }
        PREP_PREFETCH(nitem);
    }
    __syncthreads();
    {
        const int d = tid >> 2, seg = tid & 3;
        float t[16];
#pragma unroll
        for (int i = 0; i < 16; ++i) t[i] = bf2f(Ks[(seg * 16 + i) * 136 + d]) * egs[seg * 16 + i];
        *(uint4*)(KDT + d * 64 + seg * 16) = pack8(t); *(uint4*)(KDT + d * 64 + seg * 16 + 8) = pack8(t + 8);
    }
#pragma unroll
    for (int jt = 0; jt < 4; ++jt) {
        const int which = wid >> 2, it = wid & 3;
        f32x4 c = {0.f, 0.f, 0.f, 0.f};
        if (jt <= it) {
            const bf16_t* Bs = which ? Qs : Ks;
#pragma unroll
            for (int ks = 0; ks < 4; ++ks) {
                const bf16x8 af = *(const bf16x8*)(Ks + (16 * jt + lr) * 136 + 32 * ks + 8 * lq);
                const bf16x8 bf = *(const bf16x8*)(Bs + (16 * it + lr) * 136 + 32 * ks + 8 * lq);
                c = mfma16(af, bf, c);
            }
        }
        const int i = 16 * it + lr, j0 = 16 * jt + 4 * lq;
        const float gi = gcs[i];
        const float4 gj = *(const float4*)(gcs + j0);
        const float gjv[4] = {gj.x, gj.y, gj.z, gj.w};
        float v[4];
        if (which == 0) {
            const float bi = bts[i];
#pragma unroll
            for (int x = 0; x < 4; ++x) v[x] = (i > j0 + x) ? bi * c[x] * __expf(gi - gjv[x]) : 0.f;
            *(float4*)(Am + i * 68 + j0) = make_float4(v[0], v[1], v[2], v[3]);
        } else {
#pragma unroll
            for (int x = 0; x < 4; ++x) v[x] = (i >= j0 + x) ? c[x] * __expf(gi - gjv[x]) : 0.f;
            uint2 p; p.x = pk2(v[0], v[1]); p.y = pk2(v[2], v[3]);
            *(uint2*)(ATT + i * 64 + j0) = p;
        }
    }
    __syncthreads();
    if (wid == 0) {
        const int b = lane >> 4, c = lane & 15;
        float t[16];
#pragma unroll
        for (int i = 0; i < 16; ++i) t[i] = 0.f;
#pragma unroll
        for (int i = 0; i < 16; ++i) {
            float s = (i == c) ? 1.0f : 0.0f;
#pragma unroll
            for (int jq = 0; jq < (i + 3) / 4; ++jq) {
                const float4 a4 = *(const float4*)(Am + (16 * b + i) * 68 + 16 * b + 4 * jq);
                s -= a4.x * t[4 * jq]; s -= a4.y * t[4 * jq + 1]; s -= a4.z * t[4 * jq + 2]; s -= a4.w * t[4 * jq + 3];
            }
            t[i] = s;
            Tm[(16 * b + i) * 68 + 16 * b + c] = s;
        }
    }
    __syncthreads();
    {
        const int p = tid >> 8, i = (tid >> 4) & 15, j = tid & 15, r0 = 16 + 32 * p, c0 = 32 * p;
        float s = 0.f;
#pragma unroll
        for (int kq = 0; kq < 4; ++kq) { const float4 a4 = *(const float4*)(Am + (r0 + i) * 68 + c0 + 4 * kq);
            s += a4.x * Tm[(c0 + 4 * kq) * 68 + c0 + j]; s += a4.y * Tm[(c0 + 4 * kq + 1) * 68 + c0 + j]; s += a4.z * Tm[(c0 + 4 * kq + 2) * 68 + c0 + j]; s += a4.w * Tm[(c0 + 4 * kq + 3) * 68 + c0 + j]; }
        Xm[(p * 16 + i) * 36 + j] = s;
        __syncthreads();
        float u = 0.f;
#pragma unroll
        for (int kq = 0; kq < 4; ++kq) { const float4 t4 = *(const float4*)(Tm + (r0 + i) * 68 + r0 + 4 * kq);
            u += t4.x * Xm[(p * 16 + 4 * kq) * 36 + j]; u += t4.y * Xm[(p * 16 + 4 * kq + 1) * 36 + j]; u += t4.z * Xm[(p * 16 + 4 * kq + 2) * 36 + j]; u += t4.w * Xm[(p * 16 + 4 * kq + 3) * 36 + j]; }
        Tm[(r0 + i) * 68 + c0 + j] = -u;
    }
    __syncthreads();
    {
        const int i = tid >> 4, j0 = (tid & 15) * 2;
        float s0 = 0.f, s1 = 0.f;
#pragma unroll
        for (int kq = 0; kq < 8; ++kq) { const float4 a4 = *(const float4*)(Am + (32 + i) * 68 + 4 * kq);
            const float av[4] = {a4.x, a4.y, a4.z, a4.w};
#pragma unroll
            for (int e = 0; e < 4; ++e) { const float2 tv = *(const float2*)(Tm + (4 * kq + e) * 68 + j0); s0 += av[e] * tv.x; s1 += av[e] * tv.y; } }
        *(float2*)(Xm + i * 36 + j0) = make_float2(s0, s1);
        __syncthreads();
        float u0 = 0.f, u1 = 0.f;
#pragma unroll
        for (int kq = 0; kq < 8; ++kq) { const float4 t4 = *(const float4*)(Tm + (32 + i) * 68 + 32 + 4 * kq);
            const float tv4[4] = {t4.x, t4.y, t4.z, t4.w};
#pragma unroll
            for (int e = 0; e < 4; ++e) { const float2 xv = *(const float2*)(Xm + (4 * kq + e) * 36 + j0); u0 += tv4[e] * xv.x; u1 += tv4[e] * xv.y; } }
        *(float2*)(Tm + (32 + i) * 68 + j0) = make_float2(-u0, -u1);
    }
    __syncthreads();
    {
        bf16x8 tf[4][2];
#pragma unroll
        for (int rt = 0; rt < 4; ++rt)
#pragma unroll
            for (int ks = 0; ks < 2; ++ks) {
                const float4 t0 = *(const float4*)(Tm + (16 * rt + lr) * 68 + 32 * ks + 8 * lq), t1 = *(const float4*)(Tm + (16 * rt + lr) * 68 + 32 * ks + 8 * lq + 4);
                const unsigned p0 = pk2(t0.x, t0.y), p1 = pk2(t0.z, t0.w), p2 = pk2(t1.x, t1.y), p3 = pk2(t1.z, t1.w);
                bf16x8 f; f[0] = (short)(p0 & 0xffff); f[1] = (short)(p0 >> 16); f[2] = (short)(p1 & 0xffff); f[3] = (short)(p1 >> 16);
                f[4] = (short)(p2 & 0xffff); f[5] = (short)(p2 >> 16); f[6] = (short)(p3 & 0xffff); f[7] = (short)(p3 >> 16);
                tf[rt][ks] = f;
            }
#pragma unroll
        for (int mat = 0; mat < 2; ++mat) {
            const bf16_t* X = mat ? KGs : VBs;
            f32x4 c[4];
#pragma unroll
            for (int rt = 0; rt < 4; ++rt) c[rt] = (f32x4){0.f, 0.f, 0.f, 0.f};
#pragma unroll
            for (int ks = 0; ks < 2; ++ks) {
                bf16x8 xf;
#pragma unroll
                for (int jj = 0; jj < 8; ++jj) xf[jj] = (short)X[(32 * ks + 8 * lq + jj) * 136 + 16 * wid + lr];
#pragma unroll
                for (int rt = 0; rt < 4; ++rt) c[rt] = mat ? mfma16(xf, tf[rt][ks], c[rt]) : mfma16(tf[rt][ks], xf, c[rt]);
            }
            if (mat == 0) {
#pragma unroll
                for (int rt = 0; rt < 4; ++rt) *(uint2*)(UF + ((rt * 8 + wid) * 64 + lane) * 4) = pack4(c[rt]);
            } else {
#pragma unroll
                for (int rt = 0; rt < 4; ++rt) { const f32x4 n = -c[rt]; *(uint2*)(NW + (16 * rt + lr) * 128 + 16 * wid + 4 * lq) = pack4(n); }
            }
        }
    }
    __syncthreads();
}

__device__ __forceinline__ void prep_phase(const Args& a, unsigned char* lds, int l) {
    l = opaque_s(l);
    {
        const int tid = opaque_v(threadIdx.x);
        const float4* src = (const float4*)(a.in[I_CONVW] + (size_t)l * 4 * 1536); float4* dst = (float4*)(lds + PL_CW);
        for (int i = tid; i < 1536; i += 512) dst[i] = src[i];
        __syncthreads();
    }
    {
        const int tid = opaque_v(threadIdx.x), lane = tid & 63, r = tid >> 3, cgi = tid & 7;
        const bf16_t* H = (const bf16_t*)(a.ws + WS_BIG);
        uint4 raw[3][4][2]; float pbl = 0.f, pal = 0.f;
        int item = opaque_s(blockIdx.x);
        if (item < NITEM) {
            PREP_PREFETCH(item);
            if (tid < 64) { const float* lg = (const float*)(a.ws + WS_LOG) + (size_t)((item >> 2) * 64 + lane) * 8; pbl = lg[item & 3]; pal = lg[4 + (item & 3)]; }
        }
        for (; item < NITEM; item += gridDim.x) { const int nx = item + (int)gridDim.x; gdn_prep_item(a, lds, l, item, nx < NITEM ? nx : item, raw, pbl, pal); }
    }
    const bf16_t* H = (const bf16_t*)(a.ws + WS_BIG);
    for (int i = opaque_s(blockIdx.x) * 512 + opaque_v(threadIdx.x); i < 24 * 3 * 1536; i += gridDim.x * 512) {
        const int col = i % 1536, j = (i / 1536) % 3, s = i / 4608;
        if (s < 16) a.out[O_CONVP + ((size_t)(l * 16 + s) * 3 + j) * 1536 + col] = bf2f(H[(size_t)(s * 4096 + 4093 + j) * HW + col]);
        else a.out[O_CONVS + ((size_t)(l * 8 + (s - 16)) * 3 + j) * 1536 + col] = bf2f(H[(size_t)(NPROMPT + (s - 16) * 64 + 61 + j) * HW + col]);
    }
    __syncthreads();
}

__device__ __forceinline__ void scan_item(const Args& a, unsigned char* lds, int l, int sidx) {
    const int tid = opaque_v(threadIdx.x), lane = tid & 63, wid = tid >> 6, lr = lane & 15, lq = lane >> 4;
    const int wr = wid >> 2, wc = wid & 3;
    const bool sample = sidx >= 64;
    const int b = sample ? (sidx - 64) >> 2 : sidx >> 2, h = sidx & 3, nch = sample ? 1 : 64, c64_0 = sample ? 1024 + b : b * 64;
    bf16_t* ST = (bf16_t*)lds; bf16_t* VNT = (bf16_t*)(lds + 34816); bf16_t* NWs = (bf16_t*)(lds + 53248); bf16_t* QDs = (bf16_t*)(lds + 70656);
    bf16_t* KDTs = (bf16_t*)(lds + 88064); bf16_t* ATs = (bf16_t*)(lds + 106496); float* OB = (float*)(lds + 115712);
    const bf16_t* H = (const bf16_t*)(a.ws + WS_BIG); bf16_t* Y = (bf16_t*)(a.ws + WS_Y);
    const float* GL = (const float*)(a.ws + WS_GL);
    f32x4 aS[4][2];
    if (sample) {
        const float* s0 = a.in[I_SDELTA] + (size_t)((l * 8 + b) * 4 + h) * 16384;
#pragma unroll
        for (int dt = 0; dt < 4; ++dt)
#pragma unroll
            for (int et = 0; et < 2; ++et) {
#pragma unroll
                for (int x = 0; x < 4; ++x) aS[dt][et][x] = s0[(16 * (4 * wr + dt) + 4 * lq + x) * 128 + 16 * (2 * wc + et) + lr];
                *(uint2*)(ST + (16 * (2 * wc + et) + lr) * 136 + 16 * (4 * wr + dt) + 4 * lq) = pack4(aS[dt][et]);
            }
    } else {
#pragma unroll
        for (int dt = 0; dt < 4; ++dt)
#pragma unroll
            for (int et = 0; et < 2; ++et) { aS[dt][et] = (f32x4){0.f, 0.f, 0.f, 0.f}; *(uint2*)(ST + (16 * (2 * wc + et) + lr) * 136 + 16 * (4 * wr + dt) + 4 * lq) = make_uint2(0u, 0u); }
    }
    uint4 pf0, pf1, pf2, pf3, pf4, pf5, pf6; uint2 uf0, uf1, uf2, uf3; float gl;
#define SCAN_LOAD_NW(ITEM) do { const unsigned char* ib_ = (const unsigned char*)a.out + (size_t)(ITEM) * 65536; \
        pf0 = *(const uint4*)(ib_ + (size_t)tid * 16); pf1 = *(const uint4*)(ib_ + (size_t)(tid + 512) * 16); \
        pf2 = *(const uint4*)(ib_ + 32768 + (size_t)tid * 16); pf3 = *(const uint4*)(ib_ + 32768 + (size_t)(tid + 512) * 16); } while (0)
#define SCAN_LOAD(ITEM) do { const unsigned char* ib_ = (const unsigned char*)a.out + (size_t)(ITEM) * 65536; \
        pf4 = *(const uint4*)(ib_ + 49152 + (size_t)tid * 16); pf5 = *(const uint4*)(ib_ + 49152 + (size_t)(tid + 512) * 16); \
        pf6 = *(const uint4*)((const unsigned char*)(a.ws + WS_ATT) + (size_t)(ITEM) * 8192 + (size_t)tid * 16); \
        uf0 = *(const uint2*)(ib_ + 16384 + (size_t)(((2 * wr + 0) * 8 + 2 * wc + 0) * 64 + lane) * 8); \
        uf1 = *(const uint2*)(ib_ + 16384 + (size_t)(((2 * wr + 0) * 8 + 2 * wc + 1) * 64 + lane) * 8); \
        uf2 = *(const uint2*)(ib_ + 16384 + (size_t)(((2 * wr + 1) * 8 + 2 * wc + 0) * 64 + lane) * 8); \
        uf3 = *(const uint2*)(ib_ + 16384 + (size_t)(((2 * wr + 1) * 8 + 2 * wc + 1) * 64 + lane) * 8); \
        gl = GL[ITEM]; } while (0)
#define SCAN_STORE_NW() do { \
        *(uint4*)((unsigned char*)NWs + (tid >> 4) * 272 + (tid & 15) * 16) = pf0; *(uint4*)((unsigned char*)NWs + ((tid + 512) >> 4) * 272 + (tid & 15) * 16) = pf1; \
        *(uint4*)((unsigned char*)QDs + (tid >> 4) * 272 + (tid & 15) * 16) = pf2; *(uint4*)((unsigned char*)QDs + ((tid + 512) >> 4) * 272 + (tid & 15) * 16) = pf3; } while (0)
#define SCAN_STORE() do { \
        *(uint4*)((unsigned char*)KDTs + (tid >> 3) * 144 + (tid & 7) * 16) = pf4; *(uint4*)((unsigned char*)KDTs + ((tid + 512) >> 3) * 144 + (tid & 7) * 16) = pf5; \
        *(uint4*)((unsigned char*)ATs + (tid >> 3) * 144 + (tid & 7) * 16) = pf6; } while (0)
    SCAN_LOAD_NW((c64_0) * 4 + h); SCAN_LOAD((c64_0) * 4 + h);
    SCAN_STORE_NW(); SCAN_STORE();
    { const int n1 = nch > 1 ? 1 : 0; SCAN_LOAD_NW((c64_0 + n1) * 4 + h); }
    f32x4 av[2][2];
#define UF2AV(CT, ET, U) do { av[CT][ET][0] = __uint_as_float(U.x << 16); av[CT][ET][1] = __uint_as_float(U.x & 0xffff0000u); av[CT][ET][2] = __uint_as_float(U.y << 16); av[CT][ET][3] = __uint_as_float(U.y & 0xffff0000u); } while (0)
    UF2AV(0, 0, uf0); UF2AV(0, 1, uf1); UF2AV(1, 0, uf2); UF2AV(1, 1, uf3);
    float glc = gl;
    __syncthreads();
    const int r = tid >> 3, cgi = tid & 7;
    float* NGs = (float*)(lds + 149504);
    if (tid < 128) NGs[tid] = a.in[I_GNG][l * 128 + tid];
    __syncthreads();
    for (int n = 0; n < nch; ++n) {
        const int tok0 = (c64_0 + n) * 64;
        { const int nn = (n + 1 < nch) ? n + 1 : n; SCAN_LOAD((c64_0 + nn) * 4 + h); }
        bf16x8 sfr[4][2], qf[4][2];
        {
            bf16x8 nwf[4][2];
#pragma unroll
            for (int ks = 0; ks < 4; ++ks) {
#pragma unroll
                for (int et = 0; et < 2; ++et) sfr[ks][et] = *(const bf16x8*)(ST + (16 * (2 * wc + et) + lr) * 136 + 32 * ks + 8 * lq);
#pragma unroll
                for (int ct = 0; ct < 2; ++ct) nwf[ks][ct] = *(const bf16x8*)(NWs + (16 * (2 * wr + ct) + lr) * 136 + 32 * ks + 8 * lq);
            }
#pragma unroll
            for (int ks = 0; ks < 4; ++ks)
#pragma unroll
                for (int ct = 0; ct < 2; ++ct) qf[ks][ct] = *(const bf16x8*)(QDs + (16 * (2 * wr + ct) + lr) * 136 + 32 * ks + 8 * lq);
            __builtin_amdgcn_sched_barrier(0);
#pragma unroll
            for (int ks = 0; ks < 4; ++ks)
#pragma unroll
                for (int ct = 0; ct < 2; ++ct)
#pragma unroll
                    for (int et = 0; et < 2; ++et) av[ct][et] = mfma16(nwf[ks][ct], sfr[ks][et], av[ct][et]);
        }
#pragma unroll
        for (int ct = 0; ct < 2; ++ct)
#pragma unroll
            for (int et = 0; et < 2; ++et) *(uint2*)(VNT + (16 * (2 * wc + et) + lr) * 72 + 16 * (2 * wr + ct) + 4 * lq) = pack4(av[ct][et]);
        __syncthreads();
        SCAN_STORE_NW();
        { const int n2 = (n + 2 < nch) ? n + 2 : nch - 1; SCAN_LOAD_NW((c64_0 + n2) * 4 + h); }
        const uint4* zp = (const uint4*)(H + (size_t)(tok0 + r) * HW + 1536 + h * 128 + cgi * 16);
        const uint4 z0 = zp[0], z1 = zp[1];
        f32x4 ao[2][2];
#pragma unroll
        for (int ct = 0; ct < 2; ++ct)
#pragma unroll
            for (int et = 0; et < 2; ++et) ao[ct][et] = (f32x4){0.f, 0.f, 0.f, 0.f};
        {
            bf16x8 vf0[2], at0[2], kf0[4], vf1[2], at1[2], kf1[4];
#pragma unroll
            for (int et = 0; et < 2; ++et) vf0[et] = *(const bf16x8*)(VNT + (16 * (2 * wc + et) + lr) * 72 + 8 * lq);
#pragma unroll
            for (int ct = 0; ct < 2; ++ct) at0[ct] = *(const bf16x8*)(ATs + (16 * (2 * wr + ct) + lr) * 72 + 8 * lq);
#pragma unroll
            for (int dt = 0; dt < 4; ++dt) kf0[dt] = *(const bf16x8*)(KDTs + (16 * (4 * wr + dt) + lr) * 72 + 8 * lq);
            __builtin_amdgcn_sched_barrier(0);
#pragma unroll
            for (int ks = 0; ks < 4; ++ks)
#pragma unroll
                for (int ct = 0; ct < 2; ++ct)
#pragma unroll
                    for (int et = 0; et < 2; ++et) ao[ct][et] = mfma16(sfr[ks][et], qf[ks][ct], ao[ct][et]);
#pragma unroll
            for (int dt = 0; dt < 4; ++dt)
#pragma unroll
                for (int et = 0; et < 2; ++et) aS[dt][et] *= glc;
#pragma unroll
            for (int et = 0; et < 2; ++et) vf1[et] = *(const bf16x8*)(VNT + (16 * (2 * wc + et) + lr) * 72 + 32 + 8 * lq);
#pragma unroll
            for (int ct = 0; ct < 2; ++ct) at1[ct] = *(const bf16x8*)(ATs + (16 * (2 * wr + ct) + lr) * 72 + 32 + 8 * lq);
#pragma unroll
            for (int dt = 0; dt < 4; ++dt) kf1[dt] = *(const bf16x8*)(KDTs + (16 * (4 * wr + dt) + lr) * 72 + 32 + 8 * lq);
            __builtin_amdgcn_sched_barrier(0);
#pragma unroll
            for (int ct = 0; ct < 2; ++ct)
#pragma unroll
                for (int et = 0; et < 2; ++et) ao[ct][et] = mfma16(vf0[et], at0[ct], ao[ct][et]);
#pragma unroll
            for (int dt = 0; dt < 4; ++dt)
#pragma unroll
                for (int et = 0; et < 2; ++et) aS[dt][et] = mfma16(kf0[dt], vf0[et], aS[dt][et]);
#pragma unroll
            for (int ct = 0; ct < 2; ++ct)
#pragma unroll
                for (int et = 0; et < 2; ++et) ao[ct][et] = mfma16(vf1[et], at1[ct], ao[ct][et]);
#pragma unroll
            for (int dt = 0; dt < 4; ++dt)
#pragma unroll
                for (int et = 0; et < 2; ++et) aS[dt][et] = mfma16(kf1[dt], vf1[et], aS[dt][et]);
            __builtin_amdgcn_sched_barrier(0);
        }
#pragma unroll
        for (int ct = 0; ct < 2; ++ct)
#pragma unroll
            for (int et = 0; et < 2; ++et) *(float4*)(OB + (16 * (2 * wr + ct) + lr) * 132 + 16 * (2 * wc + et) + 4 * lq) = make_float4(ao[ct][et][0], ao[ct][et][1], ao[ct][et][2], ao[ct][et][3]);
        __syncthreads();
        SCAN_STORE();
        UF2AV(0, 0, uf0); UF2AV(0, 1, uf1); UF2AV(1, 0, uf2); UF2AV(1, 1, uf3);
        asm volatile("" : "+v"(gl));
        glc = gl;
#pragma unroll
        for (int dt = 0; dt < 4; ++dt)
#pragma unroll
            for (int et = 0; et < 2; ++et) *(uint2*)(ST + (16 * (2 * wc + et) + lr) * 136 + 16 * (4 * wr + dt) + 4 * lq) = pack4(aS[dt][et]);
        {
            float o[16], z[16];
#pragma unroll
            for (int i = 0; i < 4; ++i) { const float4 t = *(const float4*)(OB + r * 132 + cgi * 16 + 4 * i); o[4 * i] = t.x; o[4 * i + 1] = t.y; o[4 * i + 2] = t.z; o[4 * i + 3] = t.w; }
            float ss = 0.f;
#pragma unroll
            for (int i = 0; i < 16; ++i) ss += o[i] * o[i];
            ss = sum8(ss);
            const float rs = rsqrtf(ss * (1.0f / 128.0f) + 1e-6f);
            unpack8(z0, z); unpack8(z1, z + 8);
            float ng[16];
#pragma unroll
            for (int i = 0; i < 4; ++i) { const float4 t = *(const float4*)(NGs + cgi * 16 + 4 * i); ng[4 * i] = t.x; ng[4 * i + 1] = t.y; ng[4 * i + 2] = t.z; ng[4 * i + 3] = t.w; }
#pragma unroll
            for (int i = 0; i < 16; ++i) o[i] = o[i] * rs * ng[i] * silu_f(z[i]);
            bf16_t* yp = Y + (size_t)(tok0 + r) * DM + h * 128 + cgi * 16;
            *(uint4*)yp = pack8(o); *(uint4*)(yp + 8) = pack8(o + 8);
        }
        __syncthreads();
    }
#undef SCAN_LOAD
#undef SCAN_LOAD_NW
#undef SCAN_STORE_NW
#undef UF2AV
#undef SCAN_STORE
    float* so = a.out + (sample ? O_DELTAS + (size_t)((l * 8 + b) * 4 + h) * 16384 : O_DELTAP + (size_t)((l * 16 + b) * 4 + h) * 16384);
#pragma unroll
    for (int dt = 0; dt < 4; ++dt)
#pragma unroll
        for (int et = 0; et < 2; ++et)
#pragma unroll
            for (int x = 0; x < 4; ++x) so[(16 * (4 * wr + dt) + 4 * lq + x) * 128 + 16 * (2 * wc + et) + lr] = aS[dt][et][x];
    __syncthreads();
}

template <int NT>
__device__ __forceinline__ void smlp_item(const Args& a, unsigned char* lds, int l, int tok0, float* vout) {
    constexpr int NRT = NT / 16, NKS = NT / 32;
    const int tid = opaque_v(threadIdx.x), lane = tid & 63, wid = tid >> 6, lr = lane & 15, lq = lane >> 4;
    bf16_t* Vn = (bf16_t*)lds;
    const bf16_t* H = (const bf16_t*)(a.ws + WS_BIG); bf16_t* Y = (bf16_t*)(a.ws + WS_Y);
    {
        const float* lg = a.in[I_SLNG] + l * 512 + lane * 8; const float* lb = a.in[I_SLNB] + l * 512 + lane * 8;
        float g8[8], b8[8];
#pragma unroll
        for (int i = 0; i < 8; ++i) { g8[i] = lg[i]; b8[i] = lb[i]; }
        for (int q0 = wid; q0 < NT; q0 += 32) {
            uint4 raw[4];
#pragma unroll
            for (int u = 0; u < 4; ++u) raw[u] = *(const uint4*)(H + (size_t)(tok0 + q0 + 8 * u) * HW + 2560 + lane * 8);
            float x[4][8], sm[4], qq[4];
#pragma unroll
            for (int u = 0; u < 4; ++u) { unpack8(raw[u], x[u]); sm[u] = 0.f;
#pragma unroll
                for (int i = 0; i < 8; ++i) { x[u][i] = gelu_f(x[u][i]); sm[u] += x[u][i]; } }
#pragma unroll
            for (int u = 0; u < 4; ++u) sm[u] = wave_sum(sm[u]);
#pragma unroll
            for (int u = 0; u < 4; ++u) { const float mean = sm[u] * (1.0f / 512.0f); qq[u] = 0.f;
#pragma unroll
                for (int i = 0; i < 8; ++i) { x[u][i] -= mean; qq[u] += x[u][i] * x[u][i]; } }
#pragma unroll
            for (int u = 0; u < 4; ++u) qq[u] = wave_sum(qq[u]);
#pragma unroll
            for (int u = 0; u < 4; ++u) { const int q = q0 + 8 * u; const float rstd = rsqrtf(qq[u] * (1.0f / 512.0f) + 1e-5f);
#pragma unroll
                for (int i = 0; i < 8; ++i) x[u][i] = x[u][i] * rstd * g8[i] + b8[i];
                *(uint4*)(Vn + q * 520 + lane * 8) = pack8(x[u]);
                if (vout) { float* vp = vout + (size_t)q * 512 + lane * 8; *(float4*)vp = make_float4(x[u][0], x[u][1], x[u][2], x[u][3]); *(float4*)(vp + 4) = make_float4(x[u][4], x[u][5], x[u][6], x[u][7]); } }
        }
    }
    __syncthreads();
    {
        const int g = wid >> 1, ch = wid & 1;
        bf16x8 bfr[NKS][4];
#pragma unroll
        for (int ks = 0; ks < NKS; ++ks)
#pragma unroll
            for (int ct = 0; ct < 4; ++ct)
#pragma unroll
                for (int jj = 0; jj < 8; ++jj) bfr[ks][ct][jj] = (short)Vn[(32 * ks + 8 * lq + jj) * 520 + g * 128 + 16 * (ch * 4 + ct) + lr];
        const float* Wg = a.in[I_WS] + (size_t)(l * 4 + g) * 16384; const float* bsg = a.in[I_BS] + (l * 4 + g) * 128;
#pragma unroll 1
        for (int rt = 0; rt < NRT; ++rt) {
            f32x4 c[4];
#pragma unroll
            for (int ct = 0; ct < 4; ++ct) c[ct] = (f32x4){0.f, 0.f, 0.f, 0.f};
#pragma unroll
            for (int ks = 0; ks < NKS; ++ks) {
                if (ks <= rt / 2) {
                    const int p = 16 * rt + lr, q0 = 32 * ks + 8 * lq;
                    const float4 w0 = *(const float4*)(Wg + p * 128 + q0), w1 = *(const float4*)(Wg + p * 128 + q0 + 4);
                    float w[8] = {w0.x, w0.y, w0.z, w0.w, w1.x, w1.y, w1.z, w1.w};
#pragma unroll
                    for (int jj = 0; jj < 8; ++jj) w[jj] = (q0 + jj <= p) ? w[jj] : 0.f;
                    const uint4 pk = pack8(w);
                    bf16x8 af; af[0] = (short)(pk.x & 0xffff); af[1] = (short)(pk.x >> 16); af[2] = (short)(pk.y & 0xffff); af[3] = (short)(pk.y >> 16);
                    af[4] = (short)(pk.z & 0xffff); af[5] = (short)(pk.z >> 16); af[6] = (short)(pk.w & 0xffff); af[7] = (short)(pk.w >> 16);
#pragma unroll
                    for (int ct = 0; ct < 4; ++ct) c[ct] = mfma16(bfr[ks][ct], af, c[ct]);
                }
            }
            {
                const int p = 16 * rt + lr; const float bsp = bsg[p];
                uint2 uv[4];
#pragma unroll
                for (int ct = 0; ct < 4; ++ct) uv[ct] = *(const uint2*)(H + (size_t)(tok0 + p) * HW + 2048 + g * 128 + 16 * (ch * 4 + ct) + 4 * lq);
#pragma unroll
                for (int ct = 0; ct < 4; ++ct) {
                    const float u0 = gelu_f(__uint_as_float(uv[ct].x << 16)), u1 = gelu_f(__uint_as_float(uv[ct].x & 0xffff0000u)), u2 = gelu_f(__uint_as_float(uv[ct].y << 16)), u3 = gelu_f(__uint_as_float(uv[ct].y & 0xffff0000u));
                    uint2 yv; yv.x = pk2(u0 * (c[ct][0] + bsp), u1 * (c[ct][1] + bsp)); yv.y = pk2(u2 * (c[ct][2] + bsp), u3 * (c[ct][3] + bsp));
                    *(uint2*)(Y + (size_t)(tok0 + p) * DM + 512 + g * 128 + 16 * (ch * 4 + ct) + 4 * lq) = yv;
                }
            }
        }
    }
    __syncthreads();
}

__device__ __forceinline__ void scan_phase(const Args& a, unsigned char* lds, int l) {
    const int bid = opaque_s(blockIdx.x); l = opaque_s(l);
#ifndef NO_SCAN
    if (bid < 96) scan_item(a, lds, l, bid);
#endif
#ifndef NO_SMLP
    if (bid >= 64) {
        for (int rep = 0; rep < (REP_K == 3 ? 2 : 1); ++rep)
        for (int j = bid - 64; j < 520; j += gridDim.x - 64) {
            if (j < 512) smlp_item<128>(a, lds, l, j * 128, nullptr);
            else smlp_item<64>(a, lds, l, NPROMPT + (j - 512) * 64, a.out + O_SMLPV + (size_t)(l * 8 + (j - 512)) * 64 * 512);
        }
    }
#endif
}

__device__ __forceinline__ void small_gemm_phase(unsigned char* lds, const bf16_t* __restrict__ A, const bf16_t* __restrict__ Bt, int N, int K, bf16_t* O, int ldc, int mode, const bf16_t* X) {
    const int tid = opaque_v(threadIdx.x), lane = tid & 63, wid = tid >> 6, lr = lane & 15, lq = lane >> 4;
    const int ntiles = 16 * (N >> 6), Ks = K >> 3, nks = Ks >> 5;
    float* P = (float*)lds;
    for (int t = opaque_s(blockIdx.x); t < ntiles; t += gridDim.x) {
        const int mt = t & 15, nt = t >> 4, row0 = NPROMPT + mt * 32, col0 = nt * 64;
        f32x4 acc[2][4];
#pragma unroll
        for (int i = 0; i < 2; ++i)
#pragma unroll
            for (int j = 0; j < 4; ++j) acc[i][j] = (f32x4){0.f, 0.f, 0.f, 0.f};
        const bf16_t* ap = A + (size_t)(row0 + lr) * K + wid * Ks + 8 * lq;
        const bf16_t* bp = Bt + (size_t)(col0 + lr) * K + wid * Ks + 8 * lq;
#pragma unroll 4
        for (int ks = 0; ks < nks; ++ks) {
            bf16x8 af[2], bf[4];
#pragma unroll
            for (int i = 0; i < 2; ++i) af[i] = *(const bf16x8*)(ap + (size_t)i * 16 * K + ks * 32);
#pragma unroll
            for (int j = 0; j < 4; ++j) bf[j] = *(const bf16x8*)(bp + (size_t)j * 16 * K + ks * 32);
#pragma unroll
            for (int i = 0; i < 2; ++i)
#pragma unroll
                for (int j = 0; j < 4; ++j) acc[i][j] = mfma16(af[i], bf[j], acc[i][j]);
        }
        float* Pw = P + wid * (32 * 68);
#pragma unroll
        for (int i = 0; i < 2; ++i)
#pragma unroll
            for (int j = 0; j < 4; ++j)
#pragma unroll
                for (int x = 0; x < 4; ++x) Pw[(16 * i + 4 * lq + x) * 68 + 16 * j + lr] = acc[i][j][x];
        __syncthreads();
        {
            const int row = tid >> 4, c4 = (tid & 15) * 4;
            float4 v = *(const float4*)(P + row * 68 + c4);
#pragma unroll
            for (int w = 1; w < 8; ++w) { const float4 u = *(const float4*)(P + w * (32 * 68) + row * 68 + c4); v.x += u.x; v.y += u.y; v.z += u.z; v.w += u.w; }
            const size_t o = (size_t)(row0 + row) * ldc + col0 + c4;
            if (mode == 1) { v.x = fmaxf(v.x, 0.f); v.y = fmaxf(v.y, 0.f); v.z = fmaxf(v.z, 0.f); v.w = fmaxf(v.w, 0.f); v.x *= v.x; v.y *= v.y; v.z *= v.z; v.w *= v.w; }
            if (mode == 2) { const uint2 xv = *(const uint2*)(X + o);
                v.x += DN_ALPHA * __uint_as_float(xv.x << 16); v.y += DN_ALPHA * __uint_as_float(xv.x & 0xffff0000u); v.z += DN_ALPHA * __uint_as_float(xv.y << 16); v.w += DN_ALPHA * __uint_as_float(xv.y & 0xffff0000u); }
            uint2 p; p.x = pk2(v.x, v.y); p.y = pk2(v.z, v.w);
            *(uint2*)(O + o) = p;
        }
        __syncthreads();
    }
}

__device__ __forceinline__ void grid_bar(unsigned* ctl, unsigned round) {
    asm volatile("s_waitcnt vmcnt(0) lgkmcnt(0)" ::: "memory");
    __syncthreads();
    if (threadIdx.x == 0) {
        __builtin_amdgcn_fence(__ATOMIC_RELEASE, "agent");
        asm volatile("s_waitcnt vmcnt(0) lgkmcnt(0)" ::: "memory");
        const unsigned g = blockIdx.x & 7u, per = (gridDim.x - g + 7u) >> 3, ngrp = gridDim.x < 8u ? gridDim.x : 8u;
        const unsigned old = __hip_atomic_fetch_add(ctl + 64u * (1u + g), 1u, __ATOMIC_RELAXED, __HIP_MEMORY_SCOPE_AGENT);
        if (old + 1u == round * per) __hip_atomic_fetch_add(ctl, 1u, __ATOMIC_RELAXED, __HIP_MEMORY_SCOPE_AGENT);
        while (__hip_atomic_load(ctl, __ATOMIC_RELAXED, __HIP_MEMORY_SCOPE_AGENT) < round * ngrp) __builtin_amdgcn_s_sleep(1);
        __builtin_amdgcn_fence(__ATOMIC_ACQUIRE, "agent");
        asm volatile("s_waitcnt vmcnt(0) lgkmcnt(0)" ::: "memory");
    }
    __syncthreads();
}

__global__ void __launch_bounds__(512, 2) mega_fwd(Args a) {
    extern __shared__ __attribute__((aligned(16))) unsigned char lds[];
    cg::grid_group grid = cg::this_grid();
    unsigned nbar = 0;
    bf16_t* XB = (bf16_t*)(a.ws + WS_XB);
    bf16_t* T1 = (bf16_t*)(a.ws + WS_BIG);
    bf16_t* T2 = (bf16_t*)(a.ws + WS_T2);
    bf16_t* Hb = (bf16_t*)(a.ws + WS_BIG);
    bf16_t* Yb = (bf16_t*)(a.ws + WS_Y);
#define RUN(n) ((n) >= a.ph_lo && (n) < a.ph_hi)
#define SYNC(n) do { if ((n) > a.ph_lo) { if (a.ph_hi > 1000) grid.sync(); ++nbar; grid_bar((unsigned*)(a.ws + WS_CTL), nbar); } } while (0)
    if (RUN(0)) {
        weights_phase(a, lds);
        ln_phase<false>(a, lds, a.in[I_XP], a.in[I_XS], a.in[I_LN0G], a.in[I_LN0B], false, nullptr, nullptr, true, 0);
    }
    for (int l = 0; l < 2; ++l) {
        const int p0 = 1 + 8 * l;
        for (int k = 0; k < 8; ++k) {
            const int ph = p0 + k;
            if (!RUN(ph)) continue;
            SYNC(ph);
            for (int rep2 = 0; rep2 < ((REP_K >= 10 && k == REP_K - 10) ? 2 : 1); ++rep2) {
            if (k == 0 || k == 3 || k == 5 || k == 6) {
                pg8::Gemm g; g.M = NPROMPT; EpiAct E; E.act = 0;
                if (k == 0) { g.A = XB; g.Bt = (const bf16_t*)(a.ws + WS_WIN) + (size_t)l * HW * DM; g.N = HW; g.K = DM; E.O = Hb; E.ldc = HW; }
                else if (k == 3) { g.A = Yb; g.Bt = (const bf16_t*)(a.ws + WS_WOUT) + (size_t)l * DM * DM; g.N = DM; g.K = DM; E.O = T1; E.ldc = DM; }
                else if (k == 5) { g.A = XB; g.Bt = (const bf16_t*)(a.ws + WS_WUP) + (size_t)l * DFF * DM; g.N = DFF; g.K = DM; E.O = Hb; E.ldc = DFF; E.act = 1; }
                else { g.A = Hb; g.Bt = (const bf16_t*)(a.ws + WS_WDN) + (size_t)l * DM * DFF; g.N = DM; g.K = DFF; E.O = T2; E.ldc = DM; }
                pg8::StaticOrder S; S.init(g.M, g.N, gridDim.x, opaque_s(blockIdx.x));
#ifndef NO_GEMM
                pg8::gemm_phase<EpiAct, pg8::StaticOrder, false>((PG8_LAS unsigned char*)lds, g, S, E, nullptr);
#endif
                small_gemm_phase(lds, g.A, g.Bt, g.N, g.K, E.O, E.ldc, E.act, nullptr);
            } else if (k == 1) {
#ifndef NO_PREP
                for (int rep = 0; rep < (REP_K == 1 ? 2 : 1); ++rep) prep_phase(a, lds, l);
#endif
            } else if (k == 2) {
#ifndef NO_SCANP
                for (int rep = 0; rep < (REP_K == 2 ? 2 : 1); ++rep) scan_phase(a, lds, l);
#endif
            } else if (k == 4) {
                ln_phase<true>(a, lds, T1, T1 + (size_t)NPROMPT * DM, a.in[I_LN1G] + l * DM, a.in[I_LN1B] + l * DM, false, nullptr, nullptr, false, 0, true);
            } else {
                ln_phase<true>(a, lds, T2, T2 + (size_t)NPROMPT * DM, a.in[I_LN2G] + l * DM, a.in[I_LN2B] + l * DM, opaque_s(l) == 1, a.out, a.out + O_YS, opaque_s(l) == 0, 1, true);
            }
            }
        }
    }
#undef RUN
#undef SYNC
}

extern "C" void kernel_launch(void* const* d_in, const int* in_sizes, int n_in, void* d_out, int out_size, void* d_ws, size_t ws_size, hipStream_t stream) {
    static int grid = 0;
    if (grid == 0) {
        if (n_in != 22 || ws_size < WS_END2) { fprintf(stderr, "kernel_launch: unexpected n_in %d / ws %zu\n", n_in, ws_size); grid = -1; return; }
        int dev = 0, cus = 0, per_cu = 0;
        (void)hipGetDevice(&dev);
        (void)hipDeviceGetAttribute(&cus, hipDeviceAttributeMultiprocessorCount, dev);
        if (hipFuncSetAttribute((const void*)mega_fwd, hipFuncAttributeMaxDynamicSharedMemorySize, LDS_BYTES) != hipSuccess) { fprintf(stderr, "kernel_launch: hipFuncSetAttribute failed\n"); grid = -1; return; }
        if (hipOccupancyMaxActiveBlocksPerMultiprocessor(&per_cu, (const void*)mega_fwd, 512, LDS_BYTES) != hipSuccess || per_cu < 1) { fprintf(stderr, "kernel_launch: occupancy query says %d\n", per_cu); per_cu = 1; }
        (void)hipGetLastError();
        grid = cus * per_cu;
        fprintf(stderr, "kernel_launch: grid %d (cus %d x %d)\n", grid, cus, per_cu);
    }
    if (grid < 0) return;
    (void)hipMemsetAsync((unsigned char*)d_ws + WS_CTL, 0, 4096, stream);
    Args a{};
    for (int i = 0; i < 22; ++i) a.in[i] = (const float*)d_in[i];
    a.out = (float*)d_out; a.ws = (unsigned char*)d_ws;
#if MK_MULTI
    for (int ph = 0; ph < NPHASE; ++ph) { a.ph_lo = ph; a.ph_hi = ph + 1; hipLaunchKernelGGL(mega_fwd, dim3(grid), dim3(512), LDS_BYTES, stream, a); }
#else
    a.ph_lo = 0; a.ph_hi = NPHASE;
    void* args[] = {&a};
    hipError_t e = hipLaunchCooperativeKernel((const void*)mega_fwd, dim3(grid), dim3(512), args, LDS_BYTES, stream);
    if (e != hipSuccess) fprintf(stderr, "kernel_launch: cooperative launch failed: %s (grid %d)\n", hipGetErrorString(e), grid);
#endif
}
```
